# Optimizing an MI355X kernel written in HIP

```python
import math
import numpy as np
import jax
import jax.numpy as jnp
from jax import lax

D_MODEL = 1024
BATCH = 2
SEQ = 8192
DEPTH = 1

EPS = 1e-6
ROPE_THETA = 10000.0
NEG = -1e30

SSM_HEADS = 16
SSM_HEAD_DIM = 64
SSM_D_INNER = SSM_HEADS * SSM_HEAD_DIM
SSM_GROUPS = 4
SSM_STATE = 128
SSM_CONV = 4
SSM_CHUNK = 256
SSM_CONV_DIM = SSM_D_INNER + 2 * SSM_GROUPS * SSM_STATE

ATTN_HEADS = 16
ATTN_KV_GROUPS = 4
ATTN_HEAD_DIM = 64
ATTN_WIDTH = ATTN_HEADS * ATTN_HEAD_DIM
KV_WIDTH = ATTN_KV_GROUPS * ATTN_HEAD_DIM
CMP_BLOCK = 32
CMP_STRIDE = 16
CMP_HIDDEN = 256
SLC_BLOCK = 64
SLC_TOP_N = 16
WINDOW = 512
Q_BLOCK = 128

IN_SPLITS = (SSM_D_INNER, SSM_CONV_DIM, SSM_HEADS, ATTN_WIDTH, 6 * KV_WIDTH,
             3 * ATTN_HEADS, ATTN_WIDTH, D_MODEL, D_MODEL)
IN_TOTAL = sum(IN_SPLITS)

kernel_name = "hybrid_ssd_nsa_gated_merge"


def rms_norm(x, w):
    xf = x.astype(jnp.float32)
    y = xf * lax.rsqrt(jnp.mean(xf * xf, axis=-1, keepdims=True) + EPS)
    return (y * w.astype(jnp.float32)).astype(x.dtype)


def rope(u, pos):
    d = u.shape[-1]
    half = d // 2
    inv_freq = 1.0 / (ROPE_THETA ** (jnp.arange(half, dtype=jnp.float32) * 2.0 / d))
    ang = pos[:, None] * inv_freq[None, :]
    cos = jnp.cos(ang)[None, :, None, :]
    sin = jnp.sin(ang)[None, :, None, :]
    uf = u.astype(jnp.float32)
    u1, u2 = uf[..., :half], uf[..., half:]
    return jnp.concatenate([u1 * cos - u2 * sin, u2 * cos + u1 * sin], axis=-1).astype(u.dtype)


def causal_depthwise_conv(u, w, b):
    k, c = w.shape
    y = lax.conv_general_dilated(u, w[:, None, :].astype(u.dtype), window_strides=(1,),
                                 padding=[(k - 1, 0)], dimension_numbers=("NWC", "WIO", "NWC"),
                                 feature_group_count=c)
    return y + b.astype(u.dtype)


def segsum(a):
    t = a.shape[-1]
    cs = jnp.cumsum(a, axis=-1)
    seg = cs[..., :, None] - cs[..., None, :]
    tril = jnp.tril(jnp.ones((t, t), dtype=bool))
    return jnp.where(tril, seg, -jnp.inf)


def ssd_chunked(xh, dt, a_head, bm, cm, chunk):
    bsz, s, h, p = xh.shape
    g, n = bm.shape[2], bm.shape[3]
    r = h // g
    c = s // chunk
    x = xh.reshape(bsz, c, chunk, g, r, p)
    dtc = dt.reshape(bsz, c, chunk, g, r)
    bc = bm.reshape(bsz, c, chunk, g, n)
    cc = cm.reshape(bsz, c, chunk, g, n)
    xdt = x * dtc[..., None]
    a = jnp.moveaxis(dtc * a_head.reshape(g, r), 2, -1)
    a_cs = jnp.cumsum(a, axis=-1)
    decay = jnp.exp(segsum(a))
    cb = jnp.einsum("bclgn,bcsgn->bcgls", cc, bc)
    y_diag = jnp.einsum("bcgrls,bcsgrp->bclgrp", cb[:, :, :, None] * decay, xdt)
    decay_states = jnp.exp(a_cs[..., -1:] - a_cs)
    states = jnp.einsum("bclgn,bcgrl,bclgrp->bcgrpn", bc, decay_states, xdt)
    chunk_decay = jnp.exp(a_cs[..., -1])

    def step(carry, inp):
        st, dec = inp
        return dec[..., None, None] * carry + st, carry

    init = jnp.zeros((bsz, g, r, p, n), jnp.float32)
    _, prev = lax.scan(step, init, (jnp.moveaxis(states, 1, 0), jnp.moveaxis(chunk_decay, 1, 0)))
    prev = jnp.moveaxis(prev, 0, 1)
    y_off = jnp.einsum("bclgn,bcgrpn,bcgrl->bclgrp", cc, prev, jnp.exp(a_cs))
    return (y_diag + y_off).reshape(bsz, s, h, p)


def mamba2_branch(z, xbc, dt_raw, conv_w, conv_b, dt_bias, a_log, d_skip, norm_w):
    bsz, s, _ = xbc.shape
    xbc = jax.nn.silu(causal_depthwise_conv(xbc, conv_w, conv_b))
    xs, bm, cm = jnp.split(xbc, [SSM_D_INNER, SSM_D_INNER + SSM_GROUPS * SSM_STATE], axis=-1)
    xh = xs.reshape(bsz, s, SSM_HEADS, SSM_HEAD_DIM).astype(jnp.float32)
    bm = bm.reshape(bsz, s, SSM_GROUPS, SSM_STATE).astype(jnp.float32)
    cm = cm.reshape(bsz, s, SSM_GROUPS, SSM_STATE).astype(jnp.float32)
    dt = jax.nn.softplus(dt_raw.astype(jnp.float32) + dt_bias.astype(jnp.float32))
    a_head = -jnp.exp(a_log.astype(jnp.float32))
    chunk = math.gcd(SSM_CHUNK, s)
    y = ssd_chunked(xh, dt, a_head, bm, cm, chunk) + d_skip.astype(jnp.float32)[:, None] * xh
    y = y.reshape(bsz, s, SSM_D_INNER).astype(z.dtype)
    return rms_norm(y * jax.nn.silu(z), norm_w)


def compress_blocks(u, pos_emb, w1, b1, w2):
    bsz, s = u.shape[:2]
    nc = (s - CMP_BLOCK) // CMP_STRIDE + 1
    idx = jnp.arange(nc)[:, None] * CMP_STRIDE + jnp.arange(CMP_BLOCK)[None, :]
    blk = u[:, idx] + pos_emb[None, None, :, None, :]
    blk = blk.transpose(0, 1, 3, 2, 4).reshape(bsz, nc, ATTN_KV_GROUPS, CMP_BLOCK * ATTN_HEAD_DIM)
    return jax.nn.gelu(blk @ w1 + b1) @ w2


def overlap_matrix(nc, ns):
    c0 = np.arange(nc) * CMP_STRIDE
    c1 = c0 + CMP_BLOCK
    s0 = np.arange(ns) * SLC_BLOCK
    s1 = s0 + SLC_BLOCK
    return jnp.asarray(((c0[:, None] < s1[None, :]) & (c1[:, None] > s0[None, :])).astype(np.float32))


def masked_softmax(s, mask):
    sf = jnp.where(mask, s.astype(jnp.float32), NEG)
    return jax.nn.softmax(sf, axis=-1) * mask


def nsa_branch(q, kv, gate_raw, cmp_pos_k, cmp_pos_v, ck_w1, ck_b1, ck_w2, cv_w1, cv_b1, cv_w2):
    bsz, s = q.shape[:2]
    g, dk = ATTN_KV_GROUPS, ATTN_HEAD_DIM
    r = ATTN_HEADS // g
    pos = jnp.arange(s, dtype=jnp.float32)
    q = rope(q.reshape(bsz, s, ATTN_HEADS, dk), pos) * (dk ** -0.5)
    q = q.reshape(bsz, s, g, r, dk)
    k_cmp, v_cmp, k_slc, v_slc, k_win, v_win = [t.reshape(bsz, s, g, dk) for t in jnp.split(kv, 6, axis=-1)]
    k_cmp, k_slc, k_win = rope(k_cmp, pos), rope(k_slc, pos), rope(k_win, pos)

    k_c = compress_blocks(k_cmp, cmp_pos_k, ck_w1, ck_b1, ck_w2)
    v_c = compress_blocks(v_cmp, cmp_pos_v, cv_w1, cv_b1, cv_w2)
    nc = k_c.shape[1]
    cmp_end = jnp.arange(nc) * CMP_STRIDE + CMP_BLOCK - 1

    ns = s // SLC_BLOCK
    top_n = min(SLC_TOP_N, ns)
    ks_blk = k_slc.reshape(bsz, ns, SLC_BLOCK, g, dk).transpose(0, 3, 1, 2, 4)
    vs_blk = v_slc.reshape(bsz, ns, SLC_BLOCK, g, dk).transpose(0, 3, 1, 2, 4)
    cmp_to_slc = overlap_matrix(nc, ns)
    blk_ids = jnp.arange(ns)
    bi = jnp.arange(bsz)[:, None, None, None]
    gi = jnp.arange(g)[None, None, :, None]

    k_win_pad = jnp.pad(k_win, ((0, 0), (WINDOW, 0), (0, 0), (0, 0)))
    v_win_pad = jnp.pad(v_win, ((0, 0), (WINDOW, 0), (0, 0), (0, 0)))

    gates = jax.nn.sigmoid(gate_raw.astype(jnp.float32)).reshape(bsz, s, g, r, 3)

    def attend_block(qb_idx):
        s0 = qb_idx * Q_BLOCK
        qb = lax.dynamic_slice_in_dim(q, s0, Q_BLOCK, axis=1)
        gb = lax.dynamic_slice_in_dim(gates, s0, Q_BLOCK, axis=1)
        t = s0 + jnp.arange(Q_BLOCK)

        m_c = (cmp_end[None, :] <= t[:, None])[None, :, None, None, :]
        p_c = masked_softmax(jnp.einsum("bqgrd,bkgd->bqgrk", qb, k_c), m_c)
        o_c = jnp.einsum("bqgrk,bkgd->bqgrd", p_c.astype(v_c.dtype), v_c)

        imp = jnp.einsum("bqgk,kj->bqgj", p_c.sum(axis=3), cmp_to_slc)
        cur = t // SLC_BLOCK
        future = (blk_ids[None, :] * SLC_BLOCK > t[:, None])[None, :, None, :]
        forced = ((blk_ids[None, :] == 0) | (blk_ids[None, :] == cur[:, None])
                  | (blk_ids[None, :] == cur[:, None] - 1))[None, :, None, :]
        imp = jnp.where(future, -jnp.inf, imp)
        imp = jnp.where(forced, jnp.inf, imp)
        _, sel = lax.top_k(imp, top_n)
        ks = ks_blk[bi, gi, sel].reshape(bsz, Q_BLOCK, g, top_n * SLC_BLOCK, dk)
        vs = vs_blk[bi, gi, sel].reshape(bsz, Q_BLOCK, g, top_n * SLC_BLOCK, dk)
        pos_s = (sel[..., None] * SLC_BLOCK + jnp.arange(SLC_BLOCK)).reshape(bsz, Q_BLOCK, g, top_n * SLC_BLOCK)
        m_s = (pos_s <= t[None, :, None, None])[:, :, :, None, :]
        p_s = masked_softmax(jnp.einsum("bqgrd,bqgmd->bqgrm", qb, ks), m_s)
        o_s = jnp.einsum("bqgrm,bqgmd->bqgrd", p_s.astype(vs.dtype), vs)

        kw = lax.dynamic_slice_in_dim(k_win_pad, s0, Q_BLOCK + WINDOW, axis=1)
        vw = lax.dynamic_slice_in_dim(v_win_pad, s0, Q_BLOCK + WINDOW, axis=1)
        pos_w = s0 - WINDOW + jnp.arange(Q_BLOCK + WINDOW)
        m_w = ((pos_w[None, :] <= t[:, None]) & (pos_w[None, :] > t[:, None] - WINDOW)
               & (pos_w[None, :] >= 0))[None, :, None, None, :]
        p_w = masked_softmax(jnp.einsum("bqgrd,bkgd->bqgrk", qb, kw), m_w)
        o_w = jnp.einsum("bqgrk,bkgd->bqgrd", p_w.astype(vw.dtype), vw)

        o = gb[..., 0:1] * o_c + gb[..., 1:2] * o_s + gb[..., 2:3] * o_w
        return o.astype(q.dtype)

    out = lax.map(attend_block, jnp.arange(s // Q_BLOCK))
    return jnp.moveaxis(out, 0, 1).reshape(bsz, s, ATTN_WIDTH)


def setup_inputs(seed: int = 0) -> dict:
    key = jax.random.key(seed)
    ks = jax.random.split(key, 24)
    f32 = jnp.float32

    def nrm(k, shape, scale):
        return jax.random.normal(k, shape, f32) * scale

    fan_cmp = CMP_BLOCK * ATTN_HEAD_DIM
    dt0 = jnp.exp(jax.random.uniform(ks[5], (DEPTH, SSM_HEADS), f32, math.log(1e-3), math.log(1e-1)))
    return {
        "x": nrm(ks[0], (BATCH, SEQ, D_MODEL), 1.0),
        "norm_w": 1.0 + nrm(ks[1], (DEPTH, D_MODEL), 0.02),
        "w_in": nrm(ks[2], (DEPTH, D_MODEL, IN_TOTAL), D_MODEL ** -0.5),
        "conv_w": nrm(ks[3], (DEPTH, SSM_CONV, SSM_CONV_DIM), SSM_CONV ** -0.5),
        "conv_b": nrm(ks[4], (DEPTH, SSM_CONV_DIM), 0.01),
        "dt_bias": dt0 + jnp.log(-jnp.expm1(-dt0)),
        "a_log": jnp.log(jax.random.uniform(ks[6], (DEPTH, SSM_HEADS), f32, 1.0, 16.0)),
        "d_skip": 1.0 + nrm(ks[7], (DEPTH, SSM_HEADS), 0.1),
        "ssm_norm_w": 1.0 + nrm(ks[8], (DEPTH, SSM_D_INNER), 0.02),
        "cmp_pos_k": nrm(ks[9], (DEPTH, CMP_BLOCK, ATTN_HEAD_DIM), 0.1),
        "cmp_pos_v": nrm(ks[10], (DEPTH, CMP_BLOCK, ATTN_HEAD_DIM), 0.1),
        "cmp_k_w1": nrm(ks[11], (DEPTH, fan_cmp, CMP_HIDDEN), fan_cmp ** -0.5),
        "cmp_k_b1": nrm(ks[12], (DEPTH, CMP_HIDDEN), 0.01),
        "cmp_k_w2": nrm(ks[13], (DEPTH, CMP_HIDDEN, ATTN_HEAD_DIM), CMP_HIDDEN ** -0.5),
        "cmp_v_w1": nrm(ks[14], (DEPTH, fan_cmp, CMP_HIDDEN), fan_cmp ** -0.5),
        "cmp_v_b1": nrm(ks[15], (DEPTH, CMP_HIDDEN), 0.01),
        "cmp_v_w2": nrm(ks[16], (DEPTH, CMP_HIDDEN, ATTN_HEAD_DIM), CMP_HIDDEN ** -0.5),
        "w_branch_ssm": nrm(ks[17], (DEPTH, SSM_D_INNER, D_MODEL), SSM_D_INNER ** -0.5),
        "w_branch_attn": nrm(ks[18], (DEPTH, ATTN_WIDTH, D_MODEL), ATTN_WIDTH ** -0.5),
        "w_out": nrm(ks[19], (DEPTH, D_MODEL, D_MODEL), D_MODEL ** -0.5),
        "final_norm_w": 1.0 + nrm(ks[20], (D_MODEL,), 0.02),
    }


def reference(x, norm_w, w_in, conv_w, conv_b, dt_bias, a_log, d_skip, ssm_norm_w,
              cmp_pos_k, cmp_pos_v, cmp_k_w1, cmp_k_b1, cmp_k_w2, cmp_v_w1, cmp_v_b1, cmp_v_w2,
              w_branch_ssm, w_branch_attn, w_out, final_norm_w):
    offsets = np.cumsum(IN_SPLITS)[:-1].tolist()
    for layer in range(DEPTH):
        h = rms_norm(x, norm_w[layer])
        proj = h @ w_in[layer]
        z_ssm, xbc, dt_raw, q, kv, nsa_gate, z_attn, g_ssm, g_attn = jnp.split(proj, offsets, axis=-1)
        y_ssm = mamba2_branch(z_ssm, xbc, dt_raw, conv_w[layer], conv_b[layer], dt_bias[layer],
                              a_log[layer], d_skip[layer], ssm_norm_w[layer]) @ w_branch_ssm[layer]
        o = nsa_branch(q, kv, nsa_gate, cmp_pos_k[layer], cmp_pos_v[layer],
                       cmp_k_w1[layer], cmp_k_b1[layer], cmp_k_w2[layer],
                       cmp_v_w1[layer], cmp_v_b1[layer], cmp_v_w2[layer])
        y_attn = (o * jax.nn.silu(z_attn)) @ w_branch_attn[layer]
        merged = jax.nn.sigmoid(g_ssm) * y_ssm + jax.nn.sigmoid(g_attn) * y_attn
        x = x + merged @ w_out[layer]
    return rms_norm(x, final_norm_w)
```

```cpp
#include <hip/hip_runtime.h>
#include <hip/hip_cooperative_groups.h>
#include <cstdio>
namespace cg = cooperative_groups;

typedef unsigned short u16;
typedef unsigned long long u64;
typedef __attribute__((ext_vector_type(8))) short bf16x8;
typedef __attribute__((ext_vector_type(4))) float f32x4;
typedef __attribute__((ext_vector_type(4))) unsigned u32x4;
typedef __attribute__((ext_vector_type(4))) unsigned U4;
typedef __attribute__((ext_vector_type(2))) unsigned U2;
#define DI __device__ __forceinline__

#define NTOK 16384
#define SEQ 8192
#define DM 1024
#define IN_TOTAL 8768
#define NG1 6784
#define WT_ROWS 8832
#define EPS 1e-6f
#define LDH 1152
#define SMEM_BYTES 57344
#define SMEM_DYN (65536 + 1024)
#define RESCALE_SKIP 1

struct Params {
  const float *x, *norm_w, *w_in, *conv_w, *conv_b, *dt_bias, *a_log, *d_skip, *ssm_norm_w, *cmp_pos_k, *cmp_pos_v;
  const float *ck_w1, *ck_b1, *ck_w2, *cv_w1, *cv_b1, *cv_w2, *w_bs, *w_ba, *w_out, *final_w;
  float* out;
  u16 *hbf, *wt, *wbs_t, *wba_t, *wout_t, *w1k_t, *w1v_t, *w2k_t, *w2v_t;
  u16 *zs, *q, *kcmp, *vcmp, *kslc, *vslcT, *kwin, *vwinT, *za, *hid_k, *hid_v, *kc, *vcT, *xbc;
  float *states, *gates, *dtv, *ssq, *ssq2, *rope, *peb, *cd;
  unsigned* counter;
};


DI float bf2f(u16 v) { return __uint_as_float(((unsigned)v) << 16); }
typedef __attribute__((ext_vector_type(2))) __bf16 bf16x2_t;
typedef __attribute__((ext_vector_type(2))) float f32x2;
DI unsigned pack2(float a, float b) { f32x2 v = {a, b}; bf16x2_t r = __builtin_convertvector(v, bf16x2_t); return __builtin_bit_cast(unsigned, r); }
DI float lo_f(unsigned v) { return __uint_as_float(v << 16); }
DI float hi_f(unsigned v) { return __uint_as_float(v & 0xffff0000u); }
DI float silu_f(float x) { return x * __builtin_amdgcn_rcpf(1.f + __expf(-x)); }
DI float sigmoid_f(float x) { return __builtin_amdgcn_rcpf(1.f + __expf(-x)); }
DI float softplus_f(float x) { return fmaxf(x, 0.f) + log1pf(__expf(-fabsf(x))); }
DI float gelu_tanh(float x) { float u = 0.7978845608028654f * (x + 0.044715f * x * x * x); return 0.5f * x * (1.f + tanhf(u)); }
DI u16 f2bf(float x) { return (u16)(pack2(x, 0.f) & 0xffffu); }
DI float exp2_f(float x) { return __builtin_amdgcn_exp2f(x); }
DI f32x4 mfma16(bf16x8 a, bf16x8 b, f32x4 c) { return __builtin_amdgcn_mfma_f32_16x16x32_bf16(a, b, c, 0, 0, 0); }
DI bf16x8 as_bf16x8(U4 v) { return __builtin_bit_cast(bf16x8, v); }
DI bf16x8 as_bf16x8(unsigned a, unsigned b, unsigned c, unsigned d) { u32x4 t = {a, b, c, d}; return __builtin_bit_cast(bf16x8, t); }
DI float max3_f(float a, float b, float c) { float r; asm("v_max3_f32 %0, %1, %2, %3" : "=v"(r) : "v"(a), "v"(b), "v"(c)); return r; }
DI float quad_max(float v) {
  unsigned u = __float_as_uint(v);
  auto a = __builtin_amdgcn_permlane16_swap(u, u, false, false);
  v = max3_f(__uint_as_float(a[0]), __uint_as_float(a[1]), __uint_as_float(a[1]));
  u = __float_as_uint(v);
  auto b = __builtin_amdgcn_permlane32_swap(u, u, false, false);
  return max3_f(__uint_as_float(b[0]), __uint_as_float(b[1]), __uint_as_float(b[1]));
}
DI float quad_sum(float v) {
  unsigned u = __float_as_uint(v);
  auto a = __builtin_amdgcn_permlane16_swap(u, u, false, false);
  v = __uint_as_float(a[0]) + __uint_as_float(a[1]);
  u = __float_as_uint(v);
  auto b = __builtin_amdgcn_permlane32_swap(u, u, false, false);
  return __uint_as_float(b[0]) + __uint_as_float(b[1]);
}
typedef __attribute__((ext_vector_type(4))) short s16x4;
DI bf16x8 tr_frag(const u16* a0, const u16* a1) {
  const s16x4 x = __builtin_amdgcn_ds_read_tr16_b64_v4i16((__attribute__((address_space(3))) s16x4*)a0);
  const s16x4 y = __builtin_amdgcn_ds_read_tr16_b64_v4i16((__attribute__((address_space(3))) s16x4*)a1);
  return __builtin_shufflevector(x, y, 0, 1, 2, 3, 4, 5, 6, 7);
}
DI int otid() { int t = threadIdx.x; asm volatile("" : "+v"(t)); return t; }
DI float wave_sum(float v) {
#pragma unroll
  for (int o = 32; o > 0; o >>= 1) v += __shfl_xor(v, o, 64);
  return v;
}
DI int srccol(int n) {
  if (n < 3072) return n;
  if (n < 5632) return n + 16;
  if (n < 6656) return n + 64;
  if (n < 6704) return n - 6656 + 5648;
  if (n < 6720) return n - 6704 + 3072;
  if (n < 6784) return -1;
  return n - 6784 + 6720;
}

DI void wt_tile(const float* src, int ld_src, int k0, int n0, u16* dst, int ld_dst, int mode, const float* kscale, float* tile) {
  const int tid = otid(), nl = tid & 63, kl0 = tid >> 6;
  const int n = n0 + nl;
  const int sc = (mode == 1) ? srccol(n) : n;
#pragma unroll
  for (int i = 0; i < 16; ++i) {
    const int kl = kl0 + 4 * i;
    float v = (sc >= 0) ? __builtin_nontemporal_load(&src[(size_t)(k0 + kl) * ld_src + sc]) : 0.f;
    if (kscale) v *= kscale[k0 + kl];
    tile[kl * 65 + nl] = v;
  }
  __syncthreads();
  const int nr = tid >> 2, kc = (tid & 3) * 16;
  unsigned w[8];
#pragma unroll
  for (int e = 0; e < 8; ++e) w[e] = pack2(tile[(kc + 2 * e) * 65 + nr], tile[(kc + 2 * e + 1) * 65 + nr]);
  U4* d = (U4*)(dst + (size_t)(n0 + nr) * ld_dst + k0 + kc);
  d[0] = U4{w[0], w[1], w[2], w[3]};
  d[1] = U4{w[4], w[5], w[6], w[7]};
  __syncthreads();
}

DI void phase0(const Params& p, unsigned char* smem) {
  const int tid = otid(), lane = tid & 63, wave = tid >> 6;
  float* tile = (float*)smem;
  const int NA = 4096, NB = 138 * 16, NC = 768, ND = 256, NE = 8, NF = 1024, NGI = 64;
  const int total = NA + NB + NC + ND + NE + NF + NGI;
  for (int it = blockIdx.x; it < total; it += gridDim.x) {
    int i = it;
    if (i < NA) {
      const int row = i * 4 + wave;
      const float4* xr = (const float4*)(p.x + (size_t)row * DM);
      float4 v[4]; float ss = 0.f;
#pragma unroll
      for (int k = 0; k < 4; ++k) { const f32x4 t4 = __builtin_nontemporal_load((const f32x4*)xr + lane + 64 * k); v[k] = make_float4(t4[0], t4[1], t4[2], t4[3]); ss += v[k].x * v[k].x + v[k].y * v[k].y + v[k].z * v[k].z + v[k].w * v[k].w; }
      ss = wave_sum(ss);
      const float r = rsqrtf(ss * (1.f / DM) + EPS);
#pragma unroll
      for (int k = 0; k < 4; ++k) {
        const float4 w4 = ((const float4*)p.norm_w)[lane + 64 * k];
        U2 o; o.x = pack2(v[k].x * r * w4.x, v[k].y * r * w4.y); o.y = pack2(v[k].z * r * w4.z, v[k].w * r * w4.w);
        *(U2*)(p.hbf + (size_t)row * LDH + (lane + 64 * k) * 4) = o;
      }
      continue;
    }
    i -= NA;
    if (i < NB) { wt_tile(p.w_in, IN_TOTAL, (i & 15) * 64, (i >> 4) * 64, p.wt, LDH, 1, nullptr, tile); continue; }
    i -= NB;
    if (i < NC) {
      const int which = i >> 8, t = i & 255;
      const float* src = which == 0 ? p.w_bs : (which == 1 ? p.w_ba : p.w_out);
      u16* dst = which == 0 ? p.wbs_t : (which == 1 ? p.wba_t : p.wout_t);
      wt_tile(src, DM, (t & 15) * 64, (t >> 4) * 64, dst, DM, 0, which == 0 ? p.ssm_norm_w : nullptr, tile);
      continue;
    }
    i -= NC;
    if (i < ND) {
      const int which = i >> 7, t = i & 127;
      wt_tile(which ? p.cv_w1 : p.ck_w1, 256, (t & 31) * 64, (t >> 5) * 64, which ? p.w1v_t : p.w1k_t, 2048, 0, nullptr, tile);
      continue;
    }
    i -= ND;
    if (i < NE) {
      const int which = i >> 2, t = i & 3;
      wt_tile(which ? p.cv_w2 : p.ck_w2, 64, t * 64, 0, which ? p.w2v_t : p.w2k_t, 256, 0, nullptr, tile);
      continue;
    }
    i -= NE;
    if (i < NF) {
      const int e = i * 256 + tid; const int t = e >> 5, d = e & 31;
      const float inv = 1.0f / powf(10000.0f, (float)d * (2.0f / 64.0f));
      const float ang = (float)t * inv;
      float s, c; sincosf(ang, &s, &c);
      ((float2*)p.rope)[e] = make_float2(c, s);
      continue;
    }
    i -= NF;
    {
      const int which = i >> 5, chunk = i & 31;
      const float* w1 = which ? p.cv_w1 : p.ck_w1; const float* pe = which ? p.cmp_pos_v : p.cmp_pos_k;
      float acc = 0.f;
#pragma unroll 8
      for (int k = chunk * 64; k < chunk * 64 + 64; ++k) acc += pe[k] * w1[k * 256 + tid];
      p.peb[i * 256 + tid] = acc;
    }
  }
}

DI void glds16(const void* g, void* l) {
  __builtin_amdgcn_global_load_lds((const __attribute__((address_space(1))) unsigned*)g, (__attribute__((address_space(3))) unsigned*)l, 16, 0, 0);
}
template <int N> DI void wait_vm() { asm volatile("s_waitcnt vmcnt(%0)" ::"n"(N) : "memory"); }
DI void raw_barrier() { asm volatile("s_waitcnt lgkmcnt(0)" ::: "memory"); __builtin_amdgcn_s_barrier(); }

template <int MT, int NT>
DI void gemm_core(const u16* A, int lda, const u16* Bt, int ldb, int K, f32x4 (&acc)[MT][NT], u16* sm) {
  constexpr int BM = MT * 32, BN = NT * 32;
  constexpr int AI = BM / 32, BI = BN / 32;
  constexpr int STAGE = (BM + BN) * 128;
  static_assert(2 * STAGE <= 65536, "ring does not fit");
  unsigned char* base = (unsigned char*)sm;
  const int tid = otid(), lane = tid & 63, wave = tid >> 6, wm = wave >> 1, wn = wave & 1;
  const int l15 = lane & 15, q = lane >> 4;
  const int lrow = lane >> 3;
  const int lc = (lane & 7) ^ (((wave & 1) * 4 + (lane >> 4)) & 7);
  const u16* Ag = A + (size_t)(wave * 8 + lrow) * lda + lc * 8;
  const u16* Bg = Bt + (size_t)(wave * 8 + lrow) * ldb + lc * 8;
  const int wofs = wave * 8 * 128;
  const int nkt = K >> 6;
  raw_barrier();
#pragma unroll
  for (int i = 0; i < AI; ++i) glds16(Ag + (size_t)(i * 32) * lda, base + i * 4096 + wofs);
#pragma unroll
  for (int i = 0; i < BI; ++i) glds16(Bg + (size_t)(i * 32) * ldb, base + BM * 128 + i * 4096 + wofs);
  const int sw = (l15 >> 1) & 7;
  const int arow = (wm * MT * 16 + l15) * 128, brow = BM * 128 + (wn * NT * 16 + l15) * 128;
  int cb = 0;
  for (int kt = 0; kt < nkt; ++kt) {
    wait_vm<0>();
    raw_barrier();
    if (kt + 1 < nkt) {
      unsigned char* sb = base + (cb ^ 1) * STAGE;
      const int k0 = (kt + 1) * 64;
#pragma unroll
      for (int i = 0; i < AI; ++i) glds16(Ag + (size_t)(i * 32) * lda + k0, sb + i * 4096 + wofs);
#pragma unroll
      for (int i = 0; i < BI; ++i) glds16(Bg + (size_t)(i * 32) * ldb + k0, sb + BM * 128 + i * 4096 + wofs);
    }
    const unsigned char* cs = base + cb * STAGE;
#pragma unroll
    for (int ks = 0; ks < 2; ++ks) {
      const int pc = ((ks * 4 + q) ^ sw) * 16;
      bf16x8 af[MT], bfr[NT];
#pragma unroll
      for (int mt = 0; mt < MT; ++mt) af[mt] = *(const bf16x8*)(cs + arow + mt * 2048 + pc);
#pragma unroll
      for (int nt = 0; nt < NT; ++nt) bfr[nt] = *(const bf16x8*)(cs + brow + nt * 2048 + pc);
#pragma unroll
      for (int mt = 0; mt < MT; ++mt)
#pragma unroll
        for (int nt = 0; nt < NT; ++nt) acc[mt][nt] = mfma16(af[mt], bfr[nt], acc[mt][nt]);
    }
    cb ^= 1;
  }
}

template <int MT, int NT>
DI void zero_acc(f32x4 (&acc)[MT][NT]) {
#pragma unroll
  for (int a = 0; a < MT; ++a)
#pragma unroll
    for (int b = 0; b < NT; ++b) acc[a][b] = f32x4{0.f, 0.f, 0.f, 0.f};
}

template <int PM = 8, int PN = 8, class F>
DI void patch_walk(int MT_, int NT_, F f) {
  static_assert(PM * PN == 64, "a patch is 64 tiles");
  const int xcd = blockIdx.x & 7, local = blockIdx.x >> 3, L = gridDim.x >> 3;
  const int npc = (NT_ + PN - 1) / PN, npatch = ((MT_ + PM - 1) / PM) * npc;
  for (int s = local;; s += L) {
    const int P = (s >> 6) * 8 + xcd;
    if (P >= npatch) break;
    const int w = s & 63;
    const int mt = (P / npc) * PM + (w / PN), nt = (P % npc) * PN + (w % PN);
    if (mt < MT_ && nt < NT_) f(mt, nt);
  }
}

DI void gemm1_tile(const Params& p, int mt_i, int nt_i, unsigned char* smem) {
  const int m0 = mt_i * 128, n0 = nt_i * 128;
  f32x4 acc[4][4]; zero_acc(acc);
  gemm_core<4, 4>(p.hbf + (size_t)m0 * LDH, LDH, p.wt + (size_t)n0 * LDH, LDH, DM, acc, (u16*)smem);
  const int tid = otid(), lane = tid & 63, wave = tid >> 6, wm = wave >> 1, wn = wave & 1, l15 = lane & 15, q = lane >> 4;
  const int col0 = n0 + wn * 64, rbase = m0 + wm * 64;
#ifdef PROBE_EPIX2
#pragma unroll 1
  for (int rep = 0; rep < 2; ++rep)
#endif
  if (col0 < 1024) {
#pragma unroll
    for (int mt = 0; mt < 4; ++mt)
#pragma unroll
      for (int nt = 0; nt < 4; ++nt)
#pragma unroll
        for (int j = 0; j < 4; ++j) __builtin_nontemporal_store(f2bf(silu_f(acc[mt][nt][j])), &p.zs[(size_t)(rbase + mt * 16 + q * 4 + j) * 1024 + col0 + nt * 16 + l15]);
  } else if (col0 < 3072) {
    u16* halo = (u16*)p.states;
#pragma unroll
    for (int mt = 0; mt < 4; ++mt)
#pragma unroll
      for (int nt = 0; nt < 4; ++nt)
#pragma unroll
        for (int j = 0; j < 4; ++j) {
          const u16 v = f2bf(acc[mt][nt][j]);
          __builtin_nontemporal_store(v, &p.xbc[(size_t)(rbase + mt * 16 + q * 4 + j) * 2048 + (col0 - 1024) + nt * 16 + l15]);
          if (mt == 3 && j >= 1 && q == 3) halo[(size_t)((rbase >> 6) * 3 + (j - 1)) * 2048 + (col0 - 1024) + nt * 16 + l15] = v;
        }
  } else if (col0 < 4096) {
    const int hc = col0 - 3072;
#pragma unroll
    for (int mt = 0; mt < 4; ++mt)
#pragma unroll
      for (int j = 0; j < 4; ++j) {
        const int row = rbase + mt * 16 + q * 4 + j; const int t = row & (SEQ - 1);
#pragma unroll
        for (int nt = 0; nt < 2; ++nt) {
          const int d = nt * 16 + l15;
          const float2 cs = ((const float2*)p.rope)[t * 32 + d];
          const float u1 = acc[mt][nt][j], u2 = acc[mt][nt + 2][j];
          p.q[(size_t)row * 1024 + hc + d] = f2bf((u1 * cs.x - u2 * cs.y) * 0.18033688011112042f);
          p.q[(size_t)row * 1024 + hc + d + 32] = f2bf((u2 * cs.x + u1 * cs.y) * 0.18033688011112042f);
        }
      }
  } else if (col0 < 5632) {
    const int kc0 = col0 - 4096; const int s6 = kc0 >> 8; const int g = (kc0 & 255) >> 6;
    const int b = rbase >> 13;
    if (s6 == 3 || s6 == 5) {
      u16* dst = (s6 == 3 ? p.vslcT : p.vwinT) + (size_t)(b * 4 + g) * 64 * SEQ;
#pragma unroll
      for (int mt = 0; mt < 4; ++mt)
#pragma unroll
        for (int nt = 0; nt < 4; ++nt) {
          const int t0 = (rbase + mt * 16 + q * 4) & (SEQ - 1); const int d = nt * 16 + l15;
          U2 o; o.x = pack2(acc[mt][nt][0], acc[mt][nt][1]); o.y = pack2(acc[mt][nt][2], acc[mt][nt][3]);
          *(U2*)(dst + (size_t)d * SEQ + t0) = o;
        }
    } else if (s6 == 1) {
      u16* dst = p.vcmp + (size_t)(b * 4 + g) * SEQ * 64;
#pragma unroll
      for (int mt = 0; mt < 4; ++mt)
#pragma unroll
        for (int nt = 0; nt < 4; ++nt)
#pragma unroll
          for (int j = 0; j < 4; ++j) dst[(size_t)((rbase + mt * 16 + q * 4 + j) & (SEQ - 1)) * 64 + nt * 16 + l15] = f2bf(acc[mt][nt][j]);
    } else {
      u16* dst = (s6 == 0 ? p.kcmp : (s6 == 2 ? p.kslc : p.kwin)) + (size_t)(b * 4 + g) * SEQ * 64;
#pragma unroll
      for (int mt = 0; mt < 4; ++mt)
#pragma unroll
        for (int j = 0; j < 4; ++j) {
          const int t = (rbase + mt * 16 + q * 4 + j) & (SEQ - 1);
#pragma unroll
          for (int nt = 0; nt < 2; ++nt) {
            const int d = nt * 16 + l15;
            const float2 cs = ((const float2*)p.rope)[t * 32 + d];
            const float u1 = acc[mt][nt][j], u2 = acc[mt][nt + 2][j];
            dst[(size_t)t * 64 + d] = f2bf(u1 * cs.x - u2 * cs.y);
            dst[(size_t)t * 64 + d + 32] = f2bf(u2 * cs.x + u1 * cs.y);
          }
        }
    }
  } else if (col0 < 6656) {
#pragma unroll
    for (int mt = 0; mt < 4; ++mt)
#pragma unroll
      for (int nt = 0; nt < 4; ++nt)
#pragma unroll
        for (int j = 0; j < 4; ++j) __builtin_nontemporal_store(f2bf(silu_f(acc[mt][nt][j])), &p.za[(size_t)(rbase + mt * 16 + q * 4 + j) * 1024 + (col0 - 5632) + nt * 16 + l15]);
  } else if (col0 < 6720) {
    const float dtb = p.dt_bias[l15];
#pragma unroll
    for (int mt = 0; mt < 4; ++mt)
#pragma unroll
      for (int j = 0; j < 4; ++j) {
        const int row = rbase + mt * 16 + q * 4 + j;
#pragma unroll
        for (int nt = 0; nt < 3; ++nt) p.gates[(size_t)row * 48 + nt * 16 + l15] = sigmoid_f(acc[mt][nt][j]);
        p.dtv[(size_t)row * 16 + l15] = softplus_f(acc[mt][3][j] + dtb);
      }
  }
}

DI void gemm1_mini_tile(const Params& p, int mt_i, unsigned char* smem) {
  const int m0 = mt_i * 64;
  f32x4 acc[2][2]; zero_acc(acc);
  gemm_core<2, 2>(p.hbf + (size_t)m0 * LDH, LDH, p.wt + (size_t)6656 * LDH, LDH, DM, acc, (u16*)smem);
  const int tid = otid(), lane = tid & 63, wave = tid >> 6, wm = wave >> 1, wn = wave & 1, l15 = lane & 15, q = lane >> 4;
  const float dtb = p.dt_bias[l15];
#pragma unroll
  for (int mt = 0; mt < 2; ++mt)
#pragma unroll
    for (int j = 0; j < 4; ++j) {
      const int row = m0 + wm * 32 + mt * 16 + q * 4 + j;
      if (wn == 0) {
        p.gates[(size_t)row * 48 + l15] = sigmoid_f(acc[mt][0][j]);
        p.gates[(size_t)row * 48 + 16 + l15] = sigmoid_f(acc[mt][1][j]);
      } else {
        p.gates[(size_t)row * 48 + 32 + l15] = sigmoid_f(acc[mt][0][j]);
        p.dtv[(size_t)row * 16 + l15] = softplus_f(acc[mt][1][j] + dtb);
      }
    }
}

DI void unpack8(const U4& v, float (&f)[8]) {
  f[0] = lo_f(v.x); f[1] = hi_f(v.x); f[2] = lo_f(v.y); f[3] = hi_f(v.y); f[4] = lo_f(v.z); f[5] = hi_f(v.z); f[6] = lo_f(v.w); f[7] = hi_f(v.w);
}
template <int NCH, int RPS>
DI void conv_fetch(const Params& p, U4 (&u)[RPS + 3], int grow0, int t0, int ch0) {
  constexpr int NCG = NCH / 8;
  const int tid = otid(); const int cgi = tid % NCG, seg = tid / NCG;
  int ch = ch0 + cgi * 8;
  asm volatile("" : "+v"(ch));
  const u16* src = p.xbc + (size_t)grow0 * 2048 + ch;
  const int r0 = seg * RPS;
#pragma unroll
  for (int k = 0; k < RPS; ++k) u[k + 3] = *(const U4*)(src + (r0 + k) * 2048);
}
template <int NCH, int RPS>
DI void conv_apply(const Params& p, const U4 (&u)[RPS + 3], u16* dst, int dstride, int ch0, const float* rscale) {
  constexpr int NCG = NCH / 8;
  const int tid = otid(); const int cgi = tid % NCG, seg = tid / NCG;
  const int r0 = seg * RPS;
#pragma unroll
  for (int k = 0; k < RPS; ++k) {
    U4 v = u[k + 3];
    if (rscale) {
      float f0[8]; unpack8(v, f0);
      const float sc = rscale[r0 + k];
      v = U4{pack2(f0[0] * sc, f0[1] * sc), pack2(f0[2] * sc, f0[3] * sc), pack2(f0[4] * sc, f0[5] * sc), pack2(f0[6] * sc, f0[7] * sc)};
    }
    *(U4*)(dst + (r0 + k) * dstride + cgi * 8) = v;
  }
}
template <int NCH, int RPS>
DI void conv_load(const Params& p, u16* dst, int dstride, int grow0, int t0, int ch0, const float* rscale) {
  U4 u[RPS + 3];
  conv_fetch<NCH, RPS>(p, u, grow0, t0, ch0);
  conv_apply<NCH, RPS>(p, u, dst, dstride, ch0, rscale);
}

DI void preconv_item(const Params& p, int item) {
  const int tid = otid();
  const int slab = item >> 1, chalf = item & 1;
  const int cgi = tid & 127, rh = tid >> 7;
  const int ch = chalf * 1024 + cgi * 8;
  const int r0 = slab * 64 + rh * 32;
  float w0[8], w1[8], w2[8], w3[8], bs[8];
#pragma unroll
  for (int h = 0; h < 2; ++h) {
    const float4 a0 = *(const float4*)(p.conv_w + 0 * 2048 + ch + h * 4), a1 = *(const float4*)(p.conv_w + 1 * 2048 + ch + h * 4);
    const float4 a2 = *(const float4*)(p.conv_w + 2 * 2048 + ch + h * 4), a3 = *(const float4*)(p.conv_w + 3 * 2048 + ch + h * 4);
    const float4 bb = *(const float4*)(p.conv_b + ch + h * 4);
    w0[h * 4 + 0] = a0.x; w0[h * 4 + 1] = a0.y; w0[h * 4 + 2] = a0.z; w0[h * 4 + 3] = a0.w;
    w1[h * 4 + 0] = a1.x; w1[h * 4 + 1] = a1.y; w1[h * 4 + 2] = a1.z; w1[h * 4 + 3] = a1.w;
    w2[h * 4 + 0] = a2.x; w2[h * 4 + 1] = a2.y; w2[h * 4 + 2] = a2.z; w2[h * 4 + 3] = a2.w;
    w3[h * 4 + 0] = a3.x; w3[h * 4 + 1] = a3.y; w3[h * 4 + 2] = a3.z; w3[h * 4 + 3] = a3.w;
    bs[h * 4 + 0] = bb.x; bs[h * 4 + 1] = bb.y; bs[h * 4 + 2] = bb.z; bs[h * 4 + 3] = bb.w;
  }
  u16* xb = p.xbc + (size_t)r0 * 2048 + ch;
  const U4 z4 = U4{0u, 0u, 0u, 0u};
  U4 um3, um2, um1;
  if (rh == 1) {
    um3 = *(const U4*)(xb - 3 * 2048); um2 = *(const U4*)(xb - 2 * 2048); um1 = *(const U4*)(xb - 1 * 2048);
  } else if ((r0 & (SEQ - 1)) == 0) {
    um3 = z4; um2 = z4; um1 = z4;
  } else {
    const u16* hp = (const u16*)p.states + (size_t)((slab - 1) * 3) * 2048 + ch;
    um3 = *(const U4*)hp; um2 = *(const U4*)(hp + 2048); um1 = *(const U4*)(hp + 4096);
  }
  __syncthreads();
#pragma unroll 1
  for (int rb8 = 0; rb8 < 32; rb8 += 8) {
    U4 u[8];
#pragma unroll
    for (int k = 0; k < 8; ++k) u[k] = *(const U4*)(xb + (rb8 + k) * 2048);
#pragma unroll
    for (int k = 0; k < 8; ++k) {
      float f3[8], f2[8], f1[8], f0[8], o[8];
      unpack8(um3, f3); unpack8(um2, f2); unpack8(um1, f1); unpack8(u[k], f0);
#pragma unroll
      for (int e = 0; e < 8; ++e) o[e] = silu_f(bs[e] + w0[e] * f3[e] + w1[e] * f2[e] + w2[e] * f1[e] + w3[e] * f0[e]);
      *(U4*)(xb + (rb8 + k) * 2048) = U4{pack2(o[0], o[1]), pack2(o[2], o[3]), pack2(o[4], o[5]), pack2(o[6], o[7])};
      um3 = um2; um2 = um1; um1 = u[k];
    }
  }
}

DI float block_scan256(float v, float* tmp  ) {
  const int lane = threadIdx.x & 63, wave = threadIdx.x >> 6;
#pragma unroll
  for (int o = 1; o < 64; o <<= 1) { const float t = __shfl_up(v, o, 64); if (lane >= o) v += t; }
  if (lane == 63) tmp[wave] = v;
  __syncthreads();
  float add = 0.f;
  if (wave > 0) add += tmp[0];
  if (wave > 1) add += tmp[1];
  if (wave > 2) add += tmp[2];
  return v + add;
}
DI void scan256(float* a) {
  const int tid = otid();
  for (int off = 1; off < 256; off <<= 1) {
    const float t = (tid >= off) ? a[tid - off] : 0.f;
    __syncthreads();
    a[tid] += t;
    __syncthreads();
  }
}

DI void ssd_states_item(const Params& p, int item, unsigned char* smem) {
  const int tid = otid(), lane = tid & 63, wave = tid >> 6, l15 = lane & 15, q = lane >> 4;
  const int b = item >> 9, c = (item >> 4) & 31, h = item & 15, g = h >> 2;
  float* acs = (float*)smem; float* wsc = acs + 256;
  u16* Xs = (u16*)(smem + 2048); u16* Bs = Xs + 128 * 72;
  const int rb = b * SEQ + c * 256;
  const float A_h = -expf(p.a_log[h]);
  const float dtl = p.dtv[(size_t)(rb + tid) * 16 + h];
  __syncthreads();
  acs[tid] = block_scan256(dtl * A_h, (float*)(smem + 65536 + 16));
  __syncthreads();
  const float tot = acs[255];
  wsc[tid] = __expf(tot - acs[tid]) * dtl;
  if (tid == 255) p.cd[(b * 32 + c) * 16 + h] = __expf(tot);
  f32x4 acc[4][2]; zero_acc(acc);
  for (int half = 0; half < 2; ++half) {
    __syncthreads();
    {
      U4 ux[7], ub[11];
      conv_fetch<64, 4>(p, ux, rb + half * 128, c * 256 + half * 128, h * 64);
      conv_fetch<128, 8>(p, ub, rb + half * 128, c * 256 + half * 128, 1024 + g * 128);
      conv_apply<64, 4>(p, ux, Xs, 72, h * 64, wsc + half * 128);
      conv_apply<128, 8>(p, ub, Bs, 136, 1024 + g * 128, nullptr);
    }
    __syncthreads();
#pragma unroll
    for (int ks = 0; ks < 4; ++ks) {
      bf16x8 af[4], bfr[2];
#pragma unroll
      for (int pt = 0; pt < 4; ++pt) {
        const u16* s = Xs + (ks * 32 + q * 8 + (l15 >> 2)) * 72 + pt * 16 + (l15 & 3) * 4;
        af[pt] = tr_frag(s, s + 4 * 72);
      }
#pragma unroll
      for (int nt = 0; nt < 2; ++nt) {
        const u16* s = Bs + (ks * 32 + q * 8 + (l15 >> 2)) * 136 + (wave * 2 + nt) * 16 + (l15 & 3) * 4;
        bfr[nt] = tr_frag(s, s + 4 * 136);
      }
#pragma unroll
      for (int pt = 0; pt < 4; ++pt)
#pragma unroll
        for (int nt = 0; nt < 2; ++nt) acc[pt][nt] = mfma16(af[pt], bfr[nt], acc[pt][nt]);
    }
  }
  float* st = p.states + (size_t)item * 8192;
#pragma unroll
  for (int pt = 0; pt < 4; ++pt)
#pragma unroll
    for (int nt = 0; nt < 2; ++nt)
#pragma unroll
      for (int j = 0; j < 4; ++j) st[(pt * 16 + q * 4 + j) * 128 + (wave * 2 + nt) * 16 + l15] = acc[pt][nt][j];
}

DI void cmp_a_tile(const Params& p, int tile, unsigned char* smem) {
  const int which = tile >> 7, r = tile & 127; const int bg = r >> 4, mt_i = (r >> 1) & 7, nt_i = r & 1;
  const u16* A = (which ? p.vcmp : p.kcmp) + (size_t)bg * SEQ * 64 + (size_t)(mt_i * 64) * 1024;
  const u16* Bt = (which ? p.w1v_t : p.w1k_t) + (size_t)(nt_i * 128) * 2048;
  f32x4 acc[2][4]; zero_acc(acc);
  gemm_core<2, 4>(A, 1024, Bt, 2048, 2048, acc, (u16*)smem);
  const int tid = otid(), lane = tid & 63, wave = tid >> 6, wm = wave >> 1, wn = wave & 1, l15 = lane & 15, q = lane >> 4;
  u16* hid = which ? p.hid_v : p.hid_k;
#pragma unroll
  for (int nt = 0; nt < 4; ++nt) {
    const int col = nt_i * 128 + wn * 64 + nt * 16 + l15;
    float bias = (which ? p.cv_b1 : p.ck_b1)[col];
    for (int c = 0; c < 32; ++c) bias += p.peb[(which * 32 + c) * 256 + col];
#pragma unroll
    for (int mt = 0; mt < 2; ++mt)
#pragma unroll
      for (int j = 0; j < 4; ++j) {
        const int row = bg * 512 + mt_i * 64 + wm * 32 + mt * 16 + q * 4 + j;
        hid[(size_t)row * 256 + col] = f2bf(gelu_tanh(acc[mt][nt][j] + bias));
      }
  }
}

DI void scan_item(const Params& p, int item) {
  const int e4 = item * 256 + threadIdx.x;
  const int b = e4 >> 15, h = (e4 >> 11) & 15, r = e4 & 2047;
  float4* st = (float4*)p.states;
  float4 carry = make_float4(0.f, 0.f, 0.f, 0.f);
#pragma unroll 1
  for (int c0 = 0; c0 < 32; c0 += 16) {
    float4 sv[16]; float dv[16];
#pragma unroll
    for (int k = 0; k < 16; ++k) { sv[k] = st[(size_t)((b * 32 + c0 + k) * 16 + h) * 2048 + r]; dv[k] = p.cd[(b * 32 + c0 + k) * 16 + h]; }
#pragma unroll
    for (int k = 0; k < 16; ++k) {
      st[(size_t)((b * 32 + c0 + k) * 16 + h) * 2048 + r] = carry;
      carry.x = dv[k] * carry.x + sv[k].x; carry.y = dv[k] * carry.y + sv[k].y; carry.z = dv[k] * carry.z + sv[k].z; carry.w = dv[k] * carry.w + sv[k].w;
    }
  }
}

DI void cmp_b_tile(const Params& p, int tile, unsigned char* smem) {
  const int which = tile >> 5, mt_i = tile & 31;
  f32x4 acc[4][2]; zero_acc(acc);
  gemm_core<4, 2>((which ? p.hid_v : p.hid_k) + (size_t)(mt_i * 128) * 256, 256, which ? p.w2v_t : p.w2k_t, 256, 256, acc, (u16*)smem);
  const int tid = otid(), lane = tid & 63, wave = tid >> 6, wm = wave >> 1, wn = wave & 1, l15 = lane & 15, q = lane >> 4;
#pragma unroll
  for (int mt = 0; mt < 4; ++mt)
#pragma unroll
    for (int nt = 0; nt < 2; ++nt) {
      const int row0 = mt_i * 128 + wm * 64 + mt * 16 + q * 4; const int col = wn * 32 + nt * 16 + l15;
      const int bg = row0 >> 9, i0 = row0 & 511;
      if (which == 0) {
#pragma unroll
        for (int j = 0; j < 4; ++j) p.kc[(size_t)(row0 + j) * 64 + col] = (i0 + j == 511) ? (u16)0 : f2bf(acc[mt][nt][j]);
      } else {
        U2 o; o.x = pack2(acc[mt][nt][0], acc[mt][nt][1]); o.y = pack2(acc[mt][nt][2], (i0 + 3 == 511) ? 0.f : acc[mt][nt][3]);
        *(U2*)(p.vcT + (size_t)(bg * 64 + col) * 512 + i0) = o;
      }
    }
}

DI void ssd_y_item(const Params& p, int item, unsigned char* smem, int rep) {
  const int tid = otid(), lane = tid & 63, wave = tid >> 6, l15 = lane & 15, q = lane >> 4;
  const int b = item >> 9, c = (item >> 4) & 31, h = item & 15, g = h >> 2;
  float* acs = (float*)smem; float* dts = acs + 256;
  u16* R1 = (u16*)(smem + 2048);
  u16* Ps = (u16*)(smem + 2048 + 34816);
  u16* Bts = R1; u16* Xts = R1 + 64 * 136;
  const int rb = b * SEQ + c * 256;
  const float A_h = -expf(p.a_log[h]);
  const float Dh = p.d_skip[h];
  const float dtl = p.dtv[(size_t)(rb + tid) * 16 + h];
  __syncthreads();
  acs[tid] = block_scan256(dtl * A_h, (float*)(smem + 65536 + 16)); dts[tid] = dtl;
  __syncthreads();
  {
    const float4* st = (const float4*)(p.states + (size_t)item * 8192);
#pragma unroll
    for (int i = 0; i < 8; ++i) {
      const int idx = tid + i * 256; const float4 v = st[idx];
      U2 o; o.x = pack2(v.x, v.y); o.y = pack2(v.z, v.w);
      *(U2*)(Ps + (idx >> 5) * 136 + (idx & 31) * 4) = o;
    }
  }
  for (int lh = 0; lh < 2; ++lh) {
    __syncthreads();
    conv_load<128, 8>(p, R1, 136, rb + lh * 128, c * 256 + lh * 128, 1536 + g * 128, nullptr);
    __syncthreads();
    bf16x8 Cf[2][4]; int lrow[2]; float acl[2];
#pragma unroll
    for (int nt = 0; nt < 2; ++nt) {
      lrow[nt] = lh * 128 + wave * 32 + nt * 16 + l15; acl[nt] = acs[lrow[nt]];
#pragma unroll
      for (int ks = 0; ks < 4; ++ks) Cf[nt][ks] = *(const bf16x8*)(R1 + (wave * 32 + nt * 16 + l15) * 136 + ks * 32 + q * 8);
    }
    f32x4 O[4][2]; zero_acc(O);
#pragma unroll
    for (int dt = 0; dt < 4; ++dt)
#pragma unroll
      for (int ks = 0; ks < 4; ++ks) {
        const bf16x8 a = *(const bf16x8*)(Ps + (dt * 16 + l15) * 136 + ks * 32 + q * 8);
#pragma unroll
        for (int nt = 0; nt < 2; ++nt) O[dt][nt] = mfma16(a, Cf[nt][ks], O[dt][nt]);
      }
#pragma unroll
    for (int nt = 0; nt < 2; ++nt) {
      const float e = __expf(acl[nt]);
#pragma unroll
      for (int dt = 0; dt < 4; ++dt) O[dt][nt] *= e;
    }
    const int nsb = lh * 2 + 2;
    for (int sb = 0; sb < nsb; ++sb) {
      __syncthreads();
      {
        U4 ub[7], ux[5];
        conv_fetch<128, 4>(p, ub, rb + sb * 64, c * 256 + sb * 64, 1024 + g * 128);
        conv_fetch<64, 2>(p, ux, rb + sb * 64, c * 256 + sb * 64, h * 64);
        conv_apply<128, 4>(p, ub, Bts, 136, 1024 + g * 128, nullptr);
        conv_apply<64, 2>(p, ux, Xts, 72, h * 64, nullptr);
      }
      __syncthreads();
      if (sb * 64 <= lh * 128 + wave * 32 + 31) {
#pragma unroll 1
        for (int kp = 0; kp < 2; ++kp) {
          f32x4 S[2][2]; zero_acc(S);
#pragma unroll
          for (int k2 = 0; k2 < 2; ++k2)
#pragma unroll
            for (int ks = 0; ks < 4; ++ks) {
              const bf16x8 a = *(const bf16x8*)(Bts + (kp * 32 + k2 * 16 + l15) * 136 + ks * 32 + q * 8);
#pragma unroll
              for (int nt = 0; nt < 2; ++nt) S[k2][nt] = mfma16(a, Cf[nt][ks], S[k2][nt]);
            }
#pragma unroll
          for (int k2 = 0; k2 < 2; ++k2) {
            const int s0 = sb * 64 + kp * 32 + k2 * 16 + q * 4;
            const float4 as4 = *(const float4*)(acs + s0); const float4 dt4 = *(const float4*)(dts + s0);
            const float asv[4] = {as4.x, as4.y, as4.z, as4.w}; const float dtv4[4] = {dt4.x, dt4.y, dt4.z, dt4.w};
#pragma unroll
            for (int nt = 0; nt < 2; ++nt)
#pragma unroll
              for (int j = 0; j < 4; ++j) {
                const int sidx = s0 + j;
                float v = (sidx <= lrow[nt]) ? S[k2][nt][j] * __expf(acl[nt] - asv[j]) * dtv4[j] : 0.f;
                if (sidx == lrow[nt]) v += Dh;
                S[k2][nt][j] = v;
              }
          }
          bf16x8 P[2];
#pragma unroll
          for (int nt = 0; nt < 2; ++nt)
            P[nt] = as_bf16x8(pack2(S[0][nt][0], S[0][nt][1]), pack2(S[0][nt][2], S[0][nt][3]), pack2(S[1][nt][0], S[1][nt][1]), pack2(S[1][nt][2], S[1][nt][3]));
#pragma unroll
          for (int dt = 0; dt < 4; ++dt) {
            const u16* sx = Xts + (kp * 32 + q * 4 + (l15 >> 2)) * 72 + dt * 16 + (l15 & 3) * 4;
            const bf16x8 a = tr_frag(sx, sx + 16 * 72);
#pragma unroll
            for (int nt = 0; nt < 2; ++nt) O[dt][nt] = mfma16(a, P[nt], O[dt][nt]);
          }
        }
      }
    }
#pragma unroll
    for (int nt = 0; nt < 2; ++nt) {
      const size_t rowoff = (size_t)(rb + lrow[nt]) * 1024 + h * 64;
      float ss = 0.f;
#pragma unroll
      for (int dt = 0; dt < 4; ++dt) {
        u16* zp = p.zs + rowoff + dt * 16 + q * 4;
        const U2 zv = *(const U2*)zp;
        const float v0 = O[dt][nt][0] * lo_f(zv.x), v1 = O[dt][nt][1] * hi_f(zv.x), v2 = O[dt][nt][2] * lo_f(zv.y), v3 = O[dt][nt][3] * hi_f(zv.y);
        ss += v0 * v0 + v1 * v1 + v2 * v2 + v3 * v3;
        U2 o; o.x = pack2(v0, v1); o.y = pack2(v2, v3);
        if (rep) __builtin_nontemporal_store(o, (U2*)zp);
      }
      ss += __shfl_xor(ss, 16, 64); ss += __shfl_xor(ss, 32, 64);
      if (q == 0 && rep) p.ssq[(size_t)(rb + lrow[nt]) * 16 + h] = ss;
    }
  }
}

template <int MODE>
DI void attn_pass(unsigned char* smem, const u16* Kg, const u16* VTg, int ldv, int jb0, int jb1, u64 act0, u64 act1,
                  const bf16x8 (&Qf)[4][2], float (&m)[4], float (&ls)[4], f32x4 (&O)[4][4],
                  const int (&lo)[4], const int (&hi)[4], const u64* selrow  ,
                  const float (&invL)[4], float* imp_row  ) {
  u16* Ks = (u16*)smem; u16* Vs = Ks + 64 * 72;
  const int tid = otid(), lane = tid & 63, l15 = lane & 15, q = lane >> 4;
  U4 rk[2], rv[2];
  int jb = jb0;
  while (jb <= jb1 && !(((jb < 64 ? (act0 >> jb) : (act1 >> (jb - 64))) & 1ull))) ++jb;
  if (jb > jb1) return;
#pragma unroll
  for (int i = 0; i < 2; ++i) {
    const int ci = tid + i * 256; const int row = ci >> 3, cc = ci & 7;
    rk[i] = *(const U4*)(Kg + (size_t)(jb * 64 + row) * 64 + cc * 8);
    if (MODE != 1) rv[i] = *(const U4*)(VTg + (size_t)row * ldv + jb * 64 + cc * 8);
  }
  float carry[4] = {0.f, 0.f, 0.f, 0.f};
  while (jb <= jb1) {
    __syncthreads();
#pragma unroll
    for (int i = 0; i < 2; ++i) {
      const int ci = tid + i * 256; const int row = ci >> 3, cc = ci & 7;
      *(U4*)(Ks + row * 72 + cc * 8) = rk[i];
      if (MODE != 1) *(U4*)(Vs + row * 72 + cc * 8) = rv[i];
    }
    __syncthreads();
    int nj = jb + 1;
    while (nj <= jb1 && !(((nj < 64 ? (act0 >> nj) : (act1 >> (nj - 64))) & 1ull))) ++nj;
    if (nj <= jb1) {
#pragma unroll
      for (int i = 0; i < 2; ++i) {
        const int ci = tid + i * 256; const int row = ci >> 3, cc = ci & 7;
        rk[i] = *(const U4*)(Kg + (size_t)(nj * 64 + row) * 64 + cc * 8);
        if (MODE != 1) rv[i] = *(const U4*)(VTg + (size_t)row * ldv + nj * 64 + cc * 8);
      }
    }
    bool rowok[4]; unsigned need = 0u; bool allin = true;
#pragma unroll
    for (int nt = 0; nt < 4; ++nt) {
      rowok[nt] = selrow ? (((selrow[nt * 8 + (jb >> 6)] >> (jb & 63)) & 1ull) != 0) : true;
      if (__ballot(rowok[nt]) != 0ull) need |= 1u << nt;
      allin = allin && (lo[nt] <= jb * 64) && (jb * 64 + 63 <= hi[nt]);
    }
    const bool interior = (__ballot(!allin) == 0ull);
    if (need != 0u) {
#pragma unroll 1
    for (int half = 0; half < 2; ++half) {
      const int kbase = jb * 64 + half * 32;
      bf16x8 ka[2][2], va[4];
#pragma unroll
      for (int kt2 = 0; kt2 < 2; ++kt2) {
        const u16* kr = Ks + (half * 32 + kt2 * 16 + l15) * 72 + q * 8;
        ka[kt2][0] = *(const bf16x8*)kr; ka[kt2][1] = *(const bf16x8*)(kr + 32);
      }
      if (MODE != 1) {
#pragma unroll
        for (int dt = 0; dt < 4; ++dt) {
          const u16* vr = Vs + (dt * 16 + l15) * 72 + half * 32 + q * 4;
          const U2 v0 = *(const U2*)vr; const U2 v1 = *(const U2*)(vr + 16);
          va[dt] = as_bf16x8(v0.x, v0.y, v1.x, v1.y);
        }
      }
#pragma unroll
      for (int nt = 0; nt < 4; ++nt) {
        if (need & (1u << nt)) {
          f32x4 S[2];
#pragma unroll
          for (int kt2 = 0; kt2 < 2; ++kt2) {
            S[kt2] = mfma16(ka[kt2][0], Qf[nt][0], f32x4{0.f, 0.f, 0.f, 0.f});
            S[kt2] = mfma16(ka[kt2][1], Qf[nt][1], S[kt2]);
          }
          if (!interior) {
#pragma unroll
            for (int kt2 = 0; kt2 < 2; ++kt2)
#pragma unroll
              for (int j = 0; j < 4; ++j) {
                const int kp = kbase + kt2 * 16 + q * 4 + j;
                S[kt2][j] = (kp >= lo[nt] && kp <= hi[nt]) ? S[kt2][j] : -__builtin_inff();
              }
          }
          if (MODE != 2) {
            float ml;
            {
              const float r1 = max3_f(S[0][0], S[0][1], S[0][2]), r2 = max3_f(S[0][3], S[1][0], S[1][1]), r3 = max3_f(S[1][2], S[1][3], S[1][3]);
              ml = max3_f(r1, r2, r3);
            }
            ml = rowok[nt] ? ml : -__builtin_inff();
            if (__ballot(ml > m[nt] + 8.f) != 0ull) {
              const float mx = quad_max(max3_f(ml, m[nt], m[nt]));
              const float alpha = exp2_f(m[nt] - mx);
              m[nt] = mx;
              ls[nt] *= alpha;
              if (MODE == 0) {
#pragma unroll
                for (int dt = 0; dt < 4; ++dt) O[dt][nt] *= alpha;
              }
            }
            const float neg = rowok[nt] ? m[nt] : __builtin_inff();
#pragma unroll
            for (int kt2 = 0; kt2 < 2; ++kt2)
#pragma unroll
              for (int j = 0; j < 4; ++j) S[kt2][j] = exp2_f(S[kt2][j] - neg);
            ls[nt] += ((S[0][0] + S[0][1]) + (S[0][2] + S[0][3])) + ((S[1][0] + S[1][1]) + (S[1][2] + S[1][3]));
          } else {
            float own = 0.f;
#pragma unroll
            for (int kt2 = 0; kt2 < 2; ++kt2)
#pragma unroll
              for (int j = 0; j < 4; ++j) S[kt2][j] = exp2_f(S[kt2][j] - m[nt]) * invL[nt];
#pragma unroll
            for (int kt2 = 0; kt2 < 2; ++kt2) {
              own = (S[kt2][0] + S[kt2][1]) + (S[kt2][2] + S[kt2][3]);
              float last = S[kt2][3];
              own += __shfl_xor(own, 1, 64); own += __shfl_xor(own, 2, 64);
              last += __shfl_xor(last, 1, 64); last += __shfl_xor(last, 2, 64);
              const float up = __shfl(last, (lane + 48) & 63, 64);
              const float nb = (q > 0) ? up : carry[nt];
              carry[nt] = up;
              if ((l15 & 3) == 0) imp_row[nt * 512 + ((kbase + kt2 * 16) >> 2) + q] = own + nb;
            }
          }
          if (MODE != 1) {
            const bf16x8 P = as_bf16x8(pack2(S[0][0], S[0][1]), pack2(S[0][2], S[0][3]), pack2(S[1][0], S[1][1]), pack2(S[1][2], S[1][3]));
#pragma unroll
            for (int dt = 0; dt < 4; ++dt) O[dt][nt] = mfma16(va[dt], P, O[dt][nt]);
          }
        }
      }
    }
    }
    jb = nj;
  }
}

DI void accum_lds(unsigned* otl, const f32x4 (&O)[4][4], const float (&sc)[4], bool first) {
  const int lane = threadIdx.x & 63;
#pragma unroll
  for (int dt = 0; dt < 4; ++dt)
#pragma unroll
    for (int nt = 0; nt < 4; ++nt) {
      float v0 = O[dt][nt][0] * sc[nt], v1 = O[dt][nt][1] * sc[nt], v2 = O[dt][nt][2] * sc[nt], v3 = O[dt][nt][3] * sc[nt];
      unsigned* a = otl + ((dt * 4 + nt) * 2) * 64 + lane;
      if (!first) { const unsigned p0 = a[0], p1 = a[64]; v0 += lo_f(p0); v1 += hi_f(p0); v2 += lo_f(p1); v3 += hi_f(p1); }
      a[0] = pack2(v0, v1); a[64] = pack2(v2, v3);
    }
}

DI void attn_item(const Params& p, int cur, int bg, unsigned char* smem, int rep) {
  const int tid = otid(), lane = tid & 63, wave = tid >> 6, l15 = lane & 15, q = lane >> 4;
  const int b = bg >> 2, g = bg & 3;
  const int tl = l15 >> 2, hd = l15 & 3;
  float* imp = (float*)(smem + 18432);
  u64* sel = (u64*)(smem + 18432 + 32768);
  u64* uni = sel + 128;
  const int tokl0 = wave * 16 + tl;
  const int t0 = cur * 64 + tokl0;
  const size_t row0 = (size_t)b * SEQ + t0;
  bf16x8 Qf[4][2];
#pragma unroll
  for (int nt = 0; nt < 4; ++nt)
#pragma unroll
    for (int ks = 0; ks < 2; ++ks) Qf[nt][ks] = *(const bf16x8*)(p.q + (row0 + nt * 4) * 1024 + (g * 4 + hd) * 64 + ks * 32 + q * 8);
  float m[4], ls[4], invL[4], sc[4]; f32x4 O[4][4];
  int lo[4], hi[4];
  unsigned* otl = (unsigned*)imp + wave * 2048;
  const u64 ALL = ~0ull;
  {
  const u16* kcg = p.kc + (size_t)bg * 512 * 64; const u16* vcg = p.vcT + (size_t)bg * 64 * 512;
  const int nkb = ((4 * cur + 2) >> 6) + 1;
#pragma unroll
  for (int nt = 0; nt < 4; ++nt) { m[nt] = -1e30f; ls[nt] = 0.f; invL[nt] = 0.f; lo[nt] = 0; hi[nt] = (t0 + nt * 4 - 31) >> 4; }
  zero_acc(O);
  attn_pass<1>(smem, kcg, vcg, 512, 0, nkb - 1, ALL, ALL, Qf, m, ls, O, lo, hi, nullptr, invL, nullptr);
#pragma unroll
  for (int nt = 0; nt < 4; ++nt) {
    const float L = quad_sum(ls[nt]);
    invL[nt] = (L > 0.f) ? 1.f / L : 0.f;
  }
  attn_pass<2>(smem, kcg, vcg, 512, 0, nkb - 1, ALL, ALL, Qf, m, ls, O, lo, hi, nullptr, invL, imp + tokl0 * 128);
#pragma unroll
  for (int nt = 0; nt < 4; ++nt) sc[nt] = p.gates[(row0 + nt * 4) * 48 + (g * 4 + hd) * 3 + 0];
  __syncthreads();
  {
    u64 un0 = 0, un1 = 0;
    const u64 v0m = (cur >= 63) ? ALL : ((1ull << (cur + 1)) - 1ull);
    const u64 v1m = (cur < 64) ? 0ull : ((cur >= 127) ? ALL : ((1ull << (cur - 63)) - 1ull));
    const u64 lowm = (1ull << lane) - 1ull;
    for (int tk = 0; tk < 16; ++tk) {
      const float* rowp = imp + (wave * 16 + tk) * 128;
      const int j0 = lane, j1 = lane + 64;
      unsigned k0 = 0u, k1 = 0u;
      if (j0 <= cur) k0 = (j0 == 0 || j0 == cur || j0 == cur - 1) ? 0x7F800000u : __float_as_uint(rowp[j0]);
      if (j1 <= cur) k1 = (j1 == cur || j1 == cur - 1) ? 0x7F800000u : __float_as_uint(rowp[j1]);
      unsigned T = 0u;
      for (int bit = 30; bit >= 0; --bit) {
        const unsigned cand = T | (1u << bit);
        const int cnt = __popcll(__ballot(k0 >= cand)) + __popcll(__ballot(k1 >= cand));
        if (cnt >= 16) T = cand;
      }
      const u64 gt0 = __ballot(k0 > T), gt1 = __ballot(k1 > T);
      const int needn = 16 - (__popcll(gt0) + __popcll(gt1));
      const u64 eq0 = __ballot(k0 == T), eq1 = __ballot(k1 == T);
      const int r0 = __popcll(eq0 & lowm), r1 = __popcll(eq0) + __popcll(eq1 & lowm);
      const bool s0 = (k0 > T) || (k0 == T && r0 < needn);
      const bool s1 = (k1 > T) || (k1 == T && r1 < needn);
      const u64 b0 = __ballot(s0) & v0m, b1 = __ballot(s1) & v1m;
      if (lane == 0) { sel[(wave * 16 + tk) * 2] = b0; sel[(wave * 16 + tk) * 2 + 1] = b1; }
      un0 |= b0; un1 |= b1;
    }
    if (lane == 0) { uni[wave * 2] = un0; uni[wave * 2 + 1] = un1; }
  }
  accum_lds(otl, O, sc, true);
  __syncthreads();
  const u64 act0 = uni[0] | uni[2] | uni[4] | uni[6], act1 = uni[1] | uni[3] | uni[5] | uni[7];
#pragma unroll
  for (int nt = 0; nt < 4; ++nt) { m[nt] = -1e30f; ls[nt] = 0.f; lo[nt] = 0; hi[nt] = t0 + nt * 4; }
  zero_acc(O);
  attn_pass<0>(smem, p.kslc + (size_t)bg * SEQ * 64, p.vslcT + (size_t)bg * 64 * SEQ, SEQ, 0, cur, act0, act1, Qf, m, ls, O, lo, hi, sel + tokl0 * 2, invL, nullptr);
#pragma unroll
  for (int nt = 0; nt < 4; ++nt) {
    const float L = quad_sum(ls[nt]);
    sc[nt] = (L > 0.f) ? p.gates[(row0 + nt * 4) * 48 + (g * 4 + hd) * 3 + 1] / L : 0.f;
  }
  accum_lds(otl, O, sc, false);
#pragma unroll
  for (int nt = 0; nt < 4; ++nt) { m[nt] = -1e30f; ls[nt] = 0.f; lo[nt] = t0 + nt * 4 - 511; hi[nt] = t0 + nt * 4; }
  zero_acc(O);
  attn_pass<0>(smem, p.kwin + (size_t)bg * SEQ * 64, p.vwinT + (size_t)bg * 64 * SEQ, SEQ, (cur >= 8 ? cur - 8 : 0), cur, ALL, ALL, Qf, m, ls, O, lo, hi, nullptr, invL, nullptr);
#pragma unroll
  for (int nt = 0; nt < 4; ++nt) {
    const float L = quad_sum(ls[nt]);
    sc[nt] = (L > 0.f) ? p.gates[(row0 + nt * 4) * 48 + (g * 4 + hd) * 3 + 2] / L : 0.f;
  }
  accum_lds(otl, O, sc, false);
  if (rep == 1)
#pragma unroll
  for (int nt = 0; nt < 4; ++nt)
#pragma unroll
    for (int dt = 0; dt < 4; ++dt) {
      u16* zp = p.za + (row0 + nt * 4) * 1024 + (g * 4 + hd) * 64 + dt * 16 + q * 4;
      const U2 zv = *(const U2*)zp;
      const unsigned* a = otl + ((dt * 4 + nt) * 2) * 64 + lane;
      const unsigned p0 = a[0], p1 = a[64];
      U2 o;
      o.x = pack2(lo_f(p0) * lo_f(zv.x), hi_f(p0) * hi_f(zv.x));
      o.y = pack2(lo_f(p1) * lo_f(zv.y), hi_f(p1) * hi_f(zv.y));
      __builtin_nontemporal_store(o, (U2*)zp);
    }
  }
}

DI void gemm2_tile(const Params& p, int mt_i, int nt_i, unsigned char* smem) {
  const int m0 = mt_i * 128, n0 = nt_i * 128;
  const int tid = otid(), lane = tid & 63, wave = tid >> 6, wm = wave >> 1, wn = wave & 1, l15 = lane & 15, q = lane >> 4;
  float* rinv = (float*)(smem + 65536 + 64);
  __syncthreads();
  if (tid < 128) {
    const float* sp = p.ssq + (size_t)(m0 + tid) * 16;
    float tot = 0.f;
    for (int k = 0; k < 16; ++k) tot += sp[k];
    rinv[tid] = rsqrtf(tot * (1.f / 1024.f) + EPS);
  }
  f32x4 acc[4][4], res[4][4]; unsigned gte[4][4][2];
  zero_acc(res);
#pragma unroll 1
  for (int br = 0; br < 2; ++br) {
    zero_acc(acc);
    gemm_core<4, 4>(p.hbf + (size_t)m0 * LDH, LDH, p.wt + (size_t)(NG1 + br * 1024 + n0) * LDH, LDH, DM, acc, (u16*)smem);
#pragma unroll
    for (int a = 0; a < 4; ++a)
#pragma unroll
      for (int c = 0; c < 4; ++c) {
        gte[a][c][0] = pack2(sigmoid_f(acc[a][c][0]), sigmoid_f(acc[a][c][1]));
        gte[a][c][1] = pack2(sigmoid_f(acc[a][c][2]), sigmoid_f(acc[a][c][3]));
      }
    zero_acc(acc);
    gemm_core<4, 4>((br ? p.za : p.zs) + (size_t)m0 * DM, DM, (br ? p.wba_t : p.wbs_t) + (size_t)n0 * DM, DM, DM, acc, (u16*)smem);
#pragma unroll
    for (int a = 0; a < 4; ++a) {
      float r[4];
#pragma unroll
      for (int j = 0; j < 4; ++j) r[j] = br ? 1.f : rinv[wm * 64 + a * 16 + q * 4 + j];
#pragma unroll
      for (int c = 0; c < 4; ++c) {
        res[a][c][0] += lo_f(gte[a][c][0]) * r[0] * acc[a][c][0];
        res[a][c][1] += hi_f(gte[a][c][0]) * r[1] * acc[a][c][1];
        res[a][c][2] += lo_f(gte[a][c][1]) * r[2] * acc[a][c][2];
        res[a][c][3] += hi_f(gte[a][c][1]) * r[3] * acc[a][c][3];
      }
    }
  }
  u16* mg = p.q;
#pragma unroll
  for (int a = 0; a < 4; ++a)
#pragma unroll
    for (int c = 0; c < 4; ++c)
#pragma unroll
      for (int j = 0; j < 4; ++j) {
        const int row = m0 + wm * 64 + a * 16 + q * 4 + j; const int col = n0 + wn * 64 + c * 16 + l15;
        mg[(size_t)row * DM + col] = f2bf(res[a][c][j]);
      }
}

DI void gemm3_tile(const Params& p, int mt_i, int nt_i, unsigned char* smem) {
  const int m0 = mt_i * 128, n0 = nt_i * 128;
  const int tid = otid(), lane = tid & 63, wave = tid >> 6, wm = wave >> 1, wn = wave & 1, l15 = lane & 15, q = lane >> 4;
  f32x4 acc[4][4]; zero_acc(acc);
  gemm_core<4, 4>(p.q + (size_t)m0 * DM, DM, p.wout_t + (size_t)n0 * DM, DM, DM, acc, (u16*)smem);
#pragma unroll
  for (int mt = 0; mt < 4; ++mt)
#pragma unroll
    for (int j = 0; j < 4; ++j) {
      const int row = m0 + wm * 64 + mt * 16 + q * 4 + j;
      float ss = 0.f;
#pragma unroll
      for (int nt = 0; nt < 4; ++nt) {
        const int col = n0 + wn * 64 + nt * 16 + l15;
        const float v = acc[mt][nt][j] + __builtin_nontemporal_load(&p.x[(size_t)row * DM + col]);
        p.out[(size_t)row * DM + col] = v;
        ss += v * v;
      }
      ss += __shfl_xor(ss, 1, 64); ss += __shfl_xor(ss, 2, 64); ss += __shfl_xor(ss, 4, 64); ss += __shfl_xor(ss, 8, 64);
      if (l15 == 0) p.ssq2[(size_t)row * 16 + nt_i * 2 + wn] = ss;
    }
}

struct BarState { unsigned epoch, myx, nx_wg, n_xcc; };
DI unsigned xcc_id() { return (unsigned)__builtin_amdgcn_s_getreg((3 << 11) | 20) & 0xFu; }
DI void grid_barrier(unsigned* ctl, BarState& st) {
  st.epoch += 1;
  const unsigned epoch = st.epoch;
  __syncthreads();
  if (threadIdx.x < 64) {
    unsigned last = 0u;
    if (threadIdx.x == 0) {
      if (epoch == 1u) {
        __builtin_amdgcn_fence(__ATOMIC_RELEASE, "agent");
        const unsigned v = __hip_atomic_fetch_add(ctl, 1u, __ATOMIC_RELAXED, __HIP_MEMORY_SCOPE_AGENT) + 1u;
        last = (v == gridDim.x) ? 1u : 0u;
      } else {
        const unsigned a = __hip_atomic_fetch_add(ctl + 256 + st.myx * 32, 1u, __ATOMIC_RELAXED, __HIP_MEMORY_SCOPE_AGENT) + 1u;
        if (a == (epoch - 1u) * st.nx_wg) {
          __builtin_amdgcn_fence(__ATOMIC_RELEASE, "agent");
          const unsigned v = __hip_atomic_fetch_add(ctl + 32, 1u, __ATOMIC_RELAXED, __HIP_MEMORY_SCOPE_AGENT) + 1u;
          last = (v == (epoch - 1u) * st.n_xcc) ? 1u : 0u;
        }
      }
    }
    last = (unsigned)__builtin_amdgcn_readfirstlane((int)last);
    if (last) {
      __builtin_amdgcn_fence(__ATOMIC_ACQUIRE, "agent");
      __builtin_amdgcn_fence(__ATOMIC_RELEASE, "agent");
      for (unsigned g = threadIdx.x; g < ((gridDim.x + 7u) >> 3); g += 64u) __hip_atomic_store(ctl + 1008 + g * 32, epoch, __ATOMIC_RELAXED, __HIP_MEMORY_SCOPE_AGENT);
    }
    if (threadIdx.x == 0) {
      unsigned* f = ctl + 1008 + (blockIdx.x >> 3) * 32;
      while (__hip_atomic_load(f, __ATOMIC_RELAXED, __HIP_MEMORY_SCOPE_AGENT) < epoch) __builtin_amdgcn_s_sleep(64);
      __builtin_amdgcn_fence(__ATOMIC_ACQUIRE, "agent");
      if (epoch == 1u) {
        st.nx_wg = __hip_atomic_load(ctl + 768 + st.myx * 8, __ATOMIC_RELAXED, __HIP_MEMORY_SCOPE_AGENT);
        unsigned n = 0u;
        for (int x = 0; x < 16; ++x) n += (__hip_atomic_load(ctl + 768 + x * 8, __ATOMIC_RELAXED, __HIP_MEMORY_SCOPE_AGENT) != 0u) ? 1u : 0u;
        st.n_xcc = n;
      }
    }
  }
  __syncthreads();
}

__global__ void __launch_bounds__(256, 2) hybrid_fwd(Params p) {
  cg::grid_group grid = cg::this_grid();
  extern __shared__ __attribute__((aligned(16))) unsigned char smem[];
  const int tid = threadIdx.x;
  BarState epoch{}; unsigned* bar = p.counter + 16;
  epoch.myx = xcc_id();
  if (tid == 0) __hip_atomic_fetch_add(bar + 768 + epoch.myx * 8, 1u, __ATOMIC_RELAXED, __HIP_MEMORY_SCOPE_AGENT);
  if (p.counter == nullptr) grid.sync();
  grid_barrier(bar, epoch);
  phase0(p, smem);
#ifdef PROBE_P0X2
  phase0(p, smem);
#endif
  grid_barrier(bar, epoch);
  patch_walk<16, 4>(128, 52, [&](int mt, int nt) { gemm1_tile(p, mt, nt, smem); });
  for (int t = blockIdx.x; t < 256; t += gridDim.x) gemm1_mini_tile(p, t, smem);
#ifdef PROBE_G1X2
  patch_walk(128, 53, [&](int mt, int nt) { gemm1_tile(p, mt, nt, smem); });
#endif
  grid_barrier(bar, epoch);
  for (int t = blockIdx.x; t < 512; t += gridDim.x) preconv_item(p, t);
  grid_barrier(bar, epoch);
  {
    int* s_item = (int*)(smem + 65536);
    for (;;) {
      __syncthreads();
      if (tid == 0) *s_item = (int)atomicAdd(p.counter + 9, 1u);
      __syncthreads();
      const int t = *s_item;
      if (t >= 256 + 1024) break;
      if (t < 256) cmp_a_tile(p, t, smem); else ssd_states_item(p, t - 256, smem);
    }
  }
  grid_barrier(bar, epoch);
#ifdef PROBE_P37X2
  for (int t = blockIdx.x; t < 64 + 256; t += gridDim.x) {
    if (t < 64) cmp_b_tile(p, t, smem);
    else {
      const int e4 = (t - 64) * 256 + threadIdx.x; const int b = e4 >> 15, h = (e4 >> 11) & 15, r = e4 & 2047;
      float4* st = (float4*)p.states;
      for (int c = 0; c < 32; ++c) { const size_t idx = (size_t)((b * 32 + c) * 16 + h) * 2048 + r; float4 v = st[idx]; v.x += 0.f; st[idx] = v; }
    }
  }
#endif
  for (int t = blockIdx.x; t < 64 + 256; t += gridDim.x) { if (t < 64) cmp_b_tile(p, t, smem); else scan_item(p, t - 64); }
  grid_barrier(bar, epoch);
  {
    int* s_item = (int*)(smem + 65536);
#ifndef SKIP_ATTN
    for (;;) {
      __syncthreads();
      if (tid == 0) *s_item = (int)atomicAdd(p.counter + (blockIdx.x & 7), 1u);
      __syncthreads();
      const int item = *s_item;
#ifdef PROBE_ATTNX2
      if (item >= 256) break;
      attn_item(p, 127 - (item >> 1), blockIdx.x & 7, smem, item & 1);
#else
      if (item >= 128) break;
      attn_item(p, 127 - item, blockIdx.x & 7, smem, 1);
#endif
    }
#endif
#ifndef SKIP_SSDY
    for (;;) {
      __syncthreads();
      if (tid == 0) *s_item = (int)atomicAdd(p.counter + 8, 1u);
      __syncthreads();
      const int item = *s_item;
#ifdef PROBE_SSDYX2
      if (item >= 2048) break;
      ssd_y_item(p, item & 1023, smem, item >> 10);
#else
      if (item >= 1024) break;
      ssd_y_item(p, item, smem, 1);
#endif
    }
#endif
  }
  grid_barrier(bar, epoch);
  patch_walk(128, 8, [&](int mt, int nt) { gemm2_tile(p, mt, nt, smem); });
  grid_barrier(bar, epoch);
  patch_walk(128, 8, [&](int mt, int nt) { gemm3_tile(p, mt, nt, smem); });
  grid_barrier(bar, epoch);
#ifdef PROBE_SYNCX
  for (int i = 0; i < 10; ++i) grid_barrier(bar, epoch);
#endif
  {
    const int lane = tid & 63, wave = tid >> 6;
#ifdef PROBE_P37X2
    for (int it = blockIdx.x; it < NTOK / 4; it += gridDim.x) {
      const int row = it * 4 + wave;
      float4* o = (float4*)(p.out + (size_t)row * DM);
      for (int k = 0; k < 4; ++k) { float4 v = o[lane + 64 * k]; v.x += 0.f; o[lane + 64 * k] = v; }
    }
    __syncthreads();
#endif
    for (int it = blockIdx.x; it < NTOK / 4; it += gridDim.x) {
      const int row = it * 4 + wave;
      const float4* sp = (const float4*)(p.ssq2 + (size_t)row * 16);
      const float4 s0 = sp[0], s1 = sp[1], s2 = sp[2], s3 = sp[3];
      const float tot = ((s0.x + s0.y) + (s0.z + s0.w)) + ((s1.x + s1.y) + (s1.z + s1.w)) + ((s2.x + s2.y) + (s2.z + s2.w)) + ((s3.x + s3.y) + (s3.z + s3.w));
      const float r = rsqrtf(tot * (1.f / 1024.f) + EPS);
      float4* o = (float4*)(p.out + (size_t)row * DM);
#pragma unroll
      for (int k = 0; k < 4; ++k) {
        const f32x4 t4 = __builtin_nontemporal_load((const f32x4*)o + lane + 64 * k); float4 v = make_float4(t4[0], t4[1], t4[2], t4[3]); const float4 w = ((const float4*)p.final_w)[lane + 64 * k];
        v.x *= r * w.x; v.y *= r * w.y; v.z *= r * w.z; v.w *= r * w.w;
        __builtin_nontemporal_store(f32x4{v.x, v.y, v.z, v.w}, (f32x4*)o + lane + 64 * k);
      }
    }
  }
}

extern "C" void kernel_launch(void* const* d_in, const int* in_sizes, int n_in, void* d_out, int out_size, void* d_ws, size_t ws_size, hipStream_t stream) {
  static int grid_blocks = 0;
  if (!grid_blocks) {
    int dev = 0, cus = 0, per_cu = 0;
    hipGetDevice(&dev);
    hipDeviceGetAttribute(&cus, hipDeviceAttributeMultiprocessorCount, dev);
    hipFuncSetAttribute((const void*)hybrid_fwd, hipFuncAttributeMaxDynamicSharedMemorySize, SMEM_DYN);
    hipOccupancyMaxActiveBlocksPerMultiprocessor(&per_cu, hybrid_fwd, 256, SMEM_DYN);
    if (per_cu < 1) per_cu = 1;
    if (per_cu > 2) per_cu = 2;
    grid_blocks = cus * per_cu;
    if (grid_blocks > 768) grid_blocks = 768;
    grid_blocks &= ~7;
  }
  Params p{};
  const float* const* in = (const float* const*)d_in;
  p.x = in[0]; p.norm_w = in[1]; p.w_in = in[2]; p.conv_w = in[3]; p.conv_b = in[4]; p.dt_bias = in[5]; p.a_log = in[6]; p.d_skip = in[7];
  p.ssm_norm_w = in[8]; p.cmp_pos_k = in[9]; p.cmp_pos_v = in[10]; p.ck_w1 = in[11]; p.ck_b1 = in[12]; p.ck_w2 = in[13];
  p.cv_w1 = in[14]; p.cv_b1 = in[15]; p.cv_w2 = in[16]; p.w_bs = in[17]; p.w_ba = in[18]; p.w_out = in[19]; p.final_w = in[20];
  p.out = (float*)d_out;
  p.xbc = (u16*)d_out;
  unsigned char* w = (unsigned char*)d_ws; size_t off = 0;
  auto take = [&](size_t bytes) { unsigned char* r = w + off; off += (bytes + 255) & ~(size_t)255; return r; };
  p.hbf = (u16*)take((size_t)NTOK * LDH * 2);
  p.wt = (u16*)take((size_t)WT_ROWS * LDH * 2);
  p.wbs_t = (u16*)take((size_t)DM * DM * 2); p.wba_t = (u16*)take((size_t)DM * DM * 2); p.wout_t = (u16*)take((size_t)DM * DM * 2);
  p.w1k_t = (u16*)take((size_t)256 * 2048 * 2); p.w1v_t = (u16*)take((size_t)256 * 2048 * 2);
  p.w2k_t = (u16*)take((size_t)64 * 256 * 2); p.w2v_t = (u16*)take((size_t)64 * 256 * 2);
  p.zs = (u16*)take((size_t)NTOK * DM * 2);
  p.q = (u16*)take((size_t)NTOK * DM * 2);
  const size_t kvb = (size_t)NTOK * 256 * 2;
  p.kcmp = (u16*)take(kvb); p.vcmp = (u16*)take(kvb); p.kslc = (u16*)take(kvb); p.vslcT = (u16*)take(kvb); p.kwin = (u16*)take(kvb); p.vwinT = (u16*)take(kvb);
  p.za = (u16*)take((size_t)NTOK * DM * 2);
  p.states = (float*)take((size_t)2 * 32 * 16 * 8192 * 4);
  p.hid_k = (u16*)take((size_t)4096 * 256 * 2); p.hid_v = (u16*)take((size_t)4096 * 256 * 2);
  p.kc = (u16*)take((size_t)8 * 512 * 64 * 2); p.vcT = (u16*)take((size_t)8 * 64 * 512 * 2);
  p.gates = (float*)take((size_t)NTOK * 48 * 4);
  p.dtv = (float*)take((size_t)NTOK * 16 * 4);
  p.ssq = (float*)take((size_t)NTOK * 16 * 4); p.ssq2 = (float*)take((size_t)NTOK * 16 * 4);
  p.rope = (float*)take((size_t)SEQ * 32 * 2 * 4);
  p.peb = (float*)take(64 * 256 * 4);
  p.cd = (float*)take(2 * 32 * 16 * 4);
  p.counter = (unsigned*)take(16384);
  if (off > ws_size) { fprintf(stderr, "kernel_launch: workspace too small: need %zu, have %zu\n", off, ws_size); return; }
  if (hipMemsetAsync(p.counter, 0, 16384, stream) != hipSuccess) { fprintf(stderr, "kernel_launch: memset of control words failed\n"); return; }
  void* args[] = {&p};
  hipError_t e = hipLaunchCooperativeKernel((void*)hybrid_fwd, dim3(grid_blocks), dim3(256), args, SMEM_DYN, stream);
  if (e != hipSuccess) fprintf(stderr, "cooperative launch failed: %s (grid %d)\n", hipGetErrorString(e), grid_blocks);
}
```

```cpp
#include <hip/hip_runtime.h>
#include <hip/hip_cooperative_groups.h>
#include <cstdio>
namespace cg = cooperative_groups;

typedef unsigned short u16;
typedef unsigned long long u64;
typedef __attribute__((ext_vector_type(8))) short bf16x8;
typedef __attribute__((ext_vector_type(4))) float f32x4;
typedef __attribute__((ext_vector_type(4))) unsigned u32x4;
typedef __attribute__((ext_vector_type(4))) unsigned U4;
typedef __attribute__((ext_vector_type(2))) unsigned U2;
#define DI __device__ __forceinline__

#define NTOK 16384
#define SEQ 8192
#define DM 1024
#define IN_TOTAL 8768
#define NG1 6784
#define WT_ROWS 8832
#define EPS 1e-6f
#define LDH 1152
#define SMEM_BYTES 57344
#define SMEM_DYN (65536 + 1024)
#define RESCALE_SKIP 1

struct Params {
  const float *x, *norm_w, *w_in, *conv_w, *conv_b, *dt_bias, *a_log, *d_skip, *ssm_norm_w, *cmp_pos_k, *cmp_pos_v;
  const float *ck_w1, *ck_b1, *ck_w2, *cv_w1, *cv_b1, *cv_w2, *w_bs, *w_ba, *w_out, *final_w;
  float* out;
  u16 *hbf, *wt, *wbs_t, *wba_t, *wout_t, *w1k_t, *w1v_t, *w2k_t, *w2v_t;
  u16 *zs, *q, *kcmp, *vcmp, *kslc, *vslcT, *kwin, *vwinT, *za, *hid_k, *hid_v, *kc, *vcT, *xbc;
  float *states, *gates, *dtv, *ssq, *ssq2, *rope, *peb, *cd;
  unsigned* counter;
};


DI float bf2f(u16 v) { return __uint_as_float(((unsigned)v) << 16); }
typedef __attribute__((ext_vector_type(2))) __bf16 bf16x2_t;
typedef __attribute__((ext_vector_type(2))) float f32x2;
DI unsigned pack2(float a, float b) { f32x2 v = {a, b}; bf16x2_t r = __builtin_convertvector(v, bf16x2_t); return __builtin_bit_cast(unsigned, r); }
DI float lo_f(unsigned v) { return __uint_as_float(v << 16); }
DI float hi_f(unsigned v) { return __uint_as_float(v & 0xffff0000u); }
DI float silu_f(float x) { return x * __builtin_amdgcn_rcpf(1.f + __expf(-x)); }
DI float sigmoid_f(float x) { return __builtin_amdgcn_rcpf(1.f + __expf(-x)); }
DI float softplus_f(float x) { return fmaxf(x, 0.f) + log1pf(__expf(-fabsf(x))); }
DI float gelu_tanh(float x) { float u = 0.7978845608028654f * (x + 0.044715f * x * x * x); return 0.5f * x * (1.f + tanhf(u)); }
DI u16 f2bf(float x) { return (u16)(pack2(x, 0.f) & 0xffffu); }
DI float exp2_f(float x) { return __builtin_amdgcn_exp2f(x); }
DI f32x4 mfma16(bf16x8 a, bf16x8 b, f32x4 c) { return __builtin_amdgcn_mfma_f32_16x16x32_bf16(a, b, c, 0, 0, 0); }
DI bf16x8 as_bf16x8(U4 v) { return __builtin_bit_cast(bf16x8, v); }
DI bf16x8 as_bf16x8(unsigned a, unsigned b, unsigned c, unsigned d) { u32x4 t = {a, b, c, d}; return __builtin_bit_cast(bf16x8, t); }
DI float max3_f(float a, float b, float c) { float r; asm("v_max3_f32 %0, %1, %2, %3" : "=v"(r) : "v"(a), "v"(b), "v"(c)); return r; }
DI float quad_max(float v) {
  unsigned u = __float_as_uint(v);
  auto a = __builtin_amdgcn_permlane16_swap(u, u, false, false);
  v = max3_f(__uint_as_float(a[0]), __uint_as_float(a[1]), __uint_as_float(a[1]));
  u = __float_as_uint(v);
  auto b = __builtin_amdgcn_permlane32_swap(u, u, false, false);
  return max3_f(__uint_as_float(b[0]), __uint_as_float(b[1]), __uint_as_float(b[1]));
}
DI float quad_sum(float v) {
  unsigned u = __float_as_uint(v);
  auto a = __builtin_amdgcn_permlane16_swap(u, u, false, false);
  v = __uint_as_float(a[0]) + __uint_as_float(a[1]);
  u = __float_as_uint(v);
  auto b = __builtin_amdgcn_permlane32_swap(u, u, false, false);
  return __uint_as_float(b[0]) + __uint_as_float(b[1]);
}
typedef __attribute__((ext_vector_type(4))) short s16x4;
DI bf16x8 tr_frag(const u16* a0, const u16* a1) {
  const s16x4 x = __builtin_amdgcn_ds_read_tr16_b64_v4i16((__attribute__((address_space(3))) s16x4*)a0);
  const s16x4 y = __builtin_amdgcn_ds_read_tr16_b64_v4i16((__attribute__((address_space(3))) s16x4*)a1);
  return __builtin_shufflevector(x, y, 0, 1, 2, 3, 4, 5, 6, 7);
}
DI int otid() { int t = threadIdx.x; asm volatile("" : "+v"(t)); return t; }
DI float wave_sum(float v) {
#pragma unroll
  for (int o = 32; o > 0; o >>= 1) v += __shfl_xor(v, o, 64);
  return v;
}
DI int srccol(int n) {
  if (n < 3072) return n;
  if (n < 5632) return n + 16;
  if (n < 6656) return n + 64;
  if (n < 6704) return n - 6656 + 5648;
  if (n < 6720) return n - 6704 + 3072;
  if (n < 6784) return -1;
  return n - 6784 + 6720;
}

DI void wt_tile(const float* src, int ld_src, int k0, int n0, u16* dst, int ld_dst, int mode, const float* kscale, float* tile) {
  const int tid = otid(), n4 = (tid & 15) * 4, kl0 = tid >> 4;
  const int n = n0 + n4;
  const int sc = (mode == 1) ? srccol(n) : n;
#pragma unroll
  for (int i = 0; i < 4; ++i) {
    const int kl = kl0 + 16 * i;
    f32x4 v = {0.f, 0.f, 0.f, 0.f};
    if (sc >= 0) v = __builtin_nontemporal_load((const f32x4*)(src + (size_t)(k0 + kl) * ld_src + sc));
    if (kscale) v *= kscale[k0 + kl];
    tile[kl * 65 + n4] = v[0]; tile[kl * 65 + n4 + 1] = v[1]; tile[kl * 65 + n4 + 2] = v[2]; tile[kl * 65 + n4 + 3] = v[3];
  }
  __syncthreads();
  const int nr = tid >> 2, kc = (tid & 3) * 16;
  unsigned w[8];
#pragma unroll
  for (int e = 0; e < 8; ++e) w[e] = pack2(tile[(kc + 2 * e) * 65 + nr], tile[(kc + 2 * e + 1) * 65 + nr]);
  U4* d = (U4*)(dst + (size_t)(n0 + nr) * ld_dst + k0 + kc);
  d[0] = U4{w[0], w[1], w[2], w[3]};
  d[1] = U4{w[4], w[5], w[6], w[7]};
  __syncthreads();
}

DI void phase0(const Params& p, unsigned char* smem) {
  const int tid = otid(), lane = tid & 63, wave = tid >> 6;
  float* tile = (float*)smem;
  const int NA = 4096, NB = 138 * 16, NC = 768, ND = 256, NE = 8, NF = 1024, NGI = 64;
  const int total = NA + NB + NC + ND + NE + NF + NGI;
  for (int it = blockIdx.x; it < total; it += gridDim.x) {
    int i = it;
    if (i < NA) {
      const int row = i * 4 + wave;
      const float4* xr = (const float4*)(p.x + (size_t)row * DM);
      float4 v[4]; float ss = 0.f;
#pragma unroll
      for (int k = 0; k < 4; ++k) { const f32x4 t4 = __builtin_nontemporal_load((const f32x4*)xr + lane + 64 * k); v[k] = make_float4(t4[0], t4[1], t4[2], t4[3]); ss += v[k].x * v[k].x + v[k].y * v[k].y + v[k].z * v[k].z + v[k].w * v[k].w; }
      ss = wave_sum(ss);
      const float r = rsqrtf(ss * (1.f / DM) + EPS);
#pragma unroll
      for (int k = 0; k < 4; ++k) {
        const float4 w4 = ((const float4*)p.norm_w)[lane + 64 * k];
        U2 o; o.x = pack2(v[k].x * r * w4.x, v[k].y * r * w4.y); o.y = pack2(v[k].z * r * w4.z, v[k].w * r * w4.w);
        *(U2*)(p.hbf + (size_t)row * LDH + (lane + 64 * k) * 4) = o;
      }
      continue;
    }
    i -= NA;
    if (i < NB) { wt_tile(p.w_in, IN_TOTAL, (i & 15) * 64, (i >> 4) * 64, p.wt, LDH, 1, nullptr, tile); continue; }
    i -= NB;
    if (i < NC) {
      const int which = i >> 8, t = i & 255;
      const float* src = which == 0 ? p.w_bs : (which == 1 ? p.w_ba : p.w_out);
      u16* dst = which == 0 ? p.wbs_t : (which == 1 ? p.wba_t : p.wout_t);
      wt_tile(src, DM, (t & 15) * 64, (t >> 4) * 64, dst, DM, 0, which == 0 ? p.ssm_norm_w : nullptr, tile);
      continue;
    }
    i -= NC;
    if (i < ND) {
      const int which = i >> 7, t = i & 127;
      wt_tile(which ? p.cv_w1 : p.ck_w1, 256, (t & 31) * 64, (t >> 5) * 64, which ? p.w1v_t : p.w1k_t, 2048, 0, nullptr, tile);
      continue;
    }
    i -= ND;
    if (i < NE) {
      const int which = i >> 2, t = i & 3;
      wt_tile(which ? p.cv_w2 : p.ck_w2, 64, t * 64, 0, which ? p.w2v_t : p.w2k_t, 256, 0, nullptr, tile);
      continue;
    }
    i -= NE;
    if (i < NF) {
      const int e = i * 256 + tid; const int t = e >> 5, d = e & 31;
      const float inv = 1.0f / powf(10000.0f, (float)d * (2.0f / 64.0f));
      const float ang = (float)t * inv;
      float s, c; sincosf(ang, &s, &c);
      ((float2*)p.rope)[e] = make_float2(c, s);
      continue;
    }
    i -= NF;
    {
      const int which = i >> 5, chunk = i & 31;
      const float* w1 = which ? p.cv_w1 : p.ck_w1; const float* pe = which ? p.cmp_pos_v : p.cmp_pos_k;
      float acc = 0.f;
#pragma unroll 8
      for (int k = chunk * 64; k < chunk * 64 + 64; ++k) acc += pe[k] * w1[k * 256 + tid];
      p.peb[i * 256 + tid] = acc;
    }
  }
}

DI void glds16(const void* g, void* l) {
  __builtin_amdgcn_global_load_lds((const __attribute__((address_space(1))) unsigned*)g, (__attribute__((address_space(3))) unsigned*)l, 16, 0, 0);
}
template <int N> DI void wait_vm() { asm volatile("s_waitcnt vmcnt(%0)" ::"n"(N) : "memory"); }
DI void raw_barrier() { asm volatile("s_waitcnt lgkmcnt(0)" ::: "memory"); __builtin_amdgcn_s_barrier(); }

template <int MT, int NT>
DI void gemm_core(const u16* A, int lda, const u16* Bt, int ldb, int K, f32x4 (&acc)[MT][NT], u16* sm) {
  constexpr int BM = MT * 32, BN = NT * 32;
  constexpr int AI = BM / 32, BI = BN / 32;
  constexpr int STAGE = (BM + BN) * 128;
  static_assert(2 * STAGE <= 65536, "ring does not fit");
  unsigned char* base = (unsigned char*)sm;
  const int tid = otid(), lane = tid & 63, wave = tid >> 6, wm = wave >> 1, wn = wave & 1;
  const int l15 = lane & 15, q = lane >> 4;
  const int lrow = lane >> 3;
  const int lc = (lane & 7) ^ (((wave & 1) * 4 + (lane >> 4)) & 7);
  const u16* Ag = A + (size_t)(wave * 8 + lrow) * lda + lc * 8;
  const u16* Bg = Bt + (size_t)(wave * 8 + lrow) * ldb + lc * 8;
  const int wofs = wave * 8 * 128;
  const int nkt = K >> 6;
  raw_barrier();
#pragma unroll
  for (int i = 0; i < AI; ++i) glds16(Ag + (size_t)(i * 32) * lda, base + i * 4096 + wofs);
#pragma unroll
  for (int i = 0; i < BI; ++i) glds16(Bg + (size_t)(i * 32) * ldb, base + BM * 128 + i * 4096 + wofs);
  const int sw = (l15 >> 1) & 7;
  const int arow = (wm * MT * 16 + l15) * 128, brow = BM * 128 + (wn * NT * 16 + l15) * 128;
  int cb = 0;
  for (int kt = 0; kt < nkt; ++kt) {
    wait_vm<0>();
    raw_barrier();
    if (kt + 1 < nkt) {
      unsigned char* sb = base + (cb ^ 1) * STAGE;
      const int k0 = (kt + 1) * 64;
#pragma unroll
      for (int i = 0; i < AI; ++i) glds16(Ag + (size_t)(i * 32) * lda + k0, sb + i * 4096 + wofs);
#pragma unroll
      for (int i = 0; i < BI; ++i) glds16(Bg + (size_t)(i * 32) * ldb + k0, sb + BM * 128 + i * 4096 + wofs);
    }
    const unsigned char* cs = base + cb * STAGE;
#pragma unroll
    for (int ks = 0; ks < 2; ++ks) {
      const int pc = ((ks * 4 + q) ^ sw) * 16;
      bf16x8 af[MT], bfr[NT];
#pragma unroll
      for (int mt = 0; mt < MT; ++mt) af[mt] = *(const bf16x8*)(cs + arow + mt * 2048 + pc);
#pragma unroll
      for (int nt = 0; nt < NT; ++nt) bfr[nt] = *(const bf16x8*)(cs + brow + nt * 2048 + pc);
#pragma unroll
      for (int mt = 0; mt < MT; ++mt)
#pragma unroll
        for (int nt = 0; nt < NT; ++nt) acc[mt][nt] = mfma16(af[mt], bfr[nt], acc[mt][nt]);
    }
    cb ^= 1;
  }
}

template <int MT, int NT>
DI void zero_acc(f32x4 (&acc)[MT][NT]) {
#pragma unroll
  for (int a = 0; a < MT; ++a)
#pragma unroll
    for (int b = 0; b < NT; ++b) acc[a][b] = f32x4{0.f, 0.f, 0.f, 0.f};
}

template <int PM = 8, int PN = 8, class F>
DI void patch_walk(int MT_, int NT_, F f) {
  static_assert(PM * PN == 64, "a patch is 64 tiles");
  const int xcd = blockIdx.x & 7, local = blockIdx.x >> 3, L = gridDim.x >> 3;
  const int npc = (NT_ + PN - 1) / PN, npatch = ((MT_ + PM - 1) / PM) * npc;
  for (int s = local;; s += L) {
    const int P = (s >> 6) * 8 + xcd;
    if (P >= npatch) break;
    const int w = s & 63;
    const int mt = (P / npc) * PM + (w / PN), nt = (P % npc) * PN + (w % PN);
    if (mt < MT_ && nt < NT_) f(mt, nt);
  }
}

DI void gemm1_tile(const Params& p, int mt_i, int nt_i, unsigned char* smem) {
  const int m0 = mt_i * 128, n0 = nt_i * 128;
  f32x4 acc[4][4]; zero_acc(acc);
  gemm_core<4, 4>(p.hbf + (size_t)m0 * LDH, LDH, p.wt + (size_t)n0 * LDH, LDH, DM, acc, (u16*)smem);
  const int tid = otid(), lane = tid & 63, wave = tid >> 6, wm = wave >> 1, wn = wave & 1, l15 = lane & 15, q = lane >> 4;
  const int col0 = n0 + wn * 64, rbase = m0 + wm * 64;
#ifdef PROBE_EPIX2
#pragma unroll 1
  for (int rep = 0; rep < 2; ++rep)
#endif
  if (col0 < 1024) {
#pragma unroll
    for (int mt = 0; mt < 4; ++mt)
#pragma unroll
      for (int nt = 0; nt < 4; ++nt)
#pragma unroll
        for (int j = 0; j < 4; ++j) __builtin_nontemporal_store(f2bf(silu_f(acc[mt][nt][j])), &p.zs[(size_t)(rbase + mt * 16 + q * 4 + j) * 1024 + col0 + nt * 16 + l15]);
  } else if (col0 < 3072) {
    u16* halo = (u16*)p.states;
#pragma unroll
    for (int mt = 0; mt < 4; ++mt)
#pragma unroll
      for (int nt = 0; nt < 4; ++nt)
#pragma unroll
        for (int j = 0; j < 4; ++j) {
          const u16 v = f2bf(acc[mt][nt][j]);
          __builtin_nontemporal_store(v, &p.xbc[(size_t)(rbase + mt * 16 + q * 4 + j) * 2048 + (col0 - 1024) + nt * 16 + l15]);
          if (mt == 3 && j >= 1 && q == 3) halo[(size_t)((rbase >> 6) * 3 + (j - 1)) * 2048 + (col0 - 1024) + nt * 16 + l15] = v;
        }
  } else if (col0 < 4096) {
    const int hc = col0 - 3072;
#pragma unroll
    for (int mt = 0; mt < 4; ++mt)
#pragma unroll
      for (int j = 0; j < 4; ++j) {
        const int row = rbase + mt * 16 + q * 4 + j; const int t = row & (SEQ - 1);
#pragma unroll
        for (int nt = 0; nt < 2; ++nt) {
          const int d = nt * 16 + l15;
          const float2 cs = ((const float2*)p.rope)[t * 32 + d];
          const float u1 = acc[mt][nt][j], u2 = acc[mt][nt + 2][j];
          p.q[(size_t)row * 1024 + hc + d] = f2bf((u1 * cs.x - u2 * cs.y) * 0.18033688011112042f);
          p.q[(size_t)row * 1024 + hc + d + 32] = f2bf((u2 * cs.x + u1 * cs.y) * 0.18033688011112042f);
        }
      }
  } else if (col0 < 5632) {
    const int kc0 = col0 - 4096; const int s6 = kc0 >> 8; const int g = (kc0 & 255) >> 6;
    const int b = rbase >> 13;
    if (s6 == 3 || s6 == 5) {
      u16* dst = (s6 == 3 ? p.vslcT : p.vwinT) + (size_t)(b * 4 + g) * 64 * SEQ;
#pragma unroll
      for (int mt = 0; mt < 4; ++mt)
#pragma unroll
        for (int nt = 0; nt < 4; ++nt) {
          const int t0 = (rbase + mt * 16 + q * 4) & (SEQ - 1); const int d = nt * 16 + l15;
          U2 o; o.x = pack2(acc[mt][nt][0], acc[mt][nt][1]); o.y = pack2(acc[mt][nt][2], acc[mt][nt][3]);
          *(U2*)(dst + (size_t)d * SEQ + t0) = o;
        }
    } else if (s6 == 1) {
      u16* dst = p.vcmp + (size_t)(b * 4 + g) * SEQ * 64;
#pragma unroll
      for (int mt = 0; mt < 4; ++mt)
#pragma unroll
        for (int nt = 0; nt < 4; ++nt)
#pragma unroll
          for (int j = 0; j < 4; ++j) dst[(size_t)((rbase + mt * 16 + q * 4 + j) & (SEQ - 1)) * 64 + nt * 16 + l15] = f2bf(acc[mt][nt][j]);
    } else {
      u16* dst = (s6 == 0 ? p.kcmp : (s6 == 2 ? p.kslc : p.kwin)) + (size_t)(b * 4 + g) * SEQ * 64;
#pragma unroll
      for (int mt = 0; mt < 4; ++mt)
#pragma unroll
        for (int j = 0; j < 4; ++j) {
          const int t = (rbase + mt * 16 + q * 4 + j) & (SEQ - 1);
#pragma unroll
          for (int nt = 0; nt < 2; ++nt) {
            const int d = nt * 16 + l15;
            const float2 cs = ((const float2*)p.rope)[t * 32 + d];
            const float u1 = acc[mt][nt][j], u2 = acc[mt][nt + 2][j];
            dst[(size_t)t * 64 + d] = f2bf(u1 * cs.x - u2 * cs.y);
            dst[(size_t)t * 64 + d + 32] = f2bf(u2 * cs.x + u1 * cs.y);
          }
        }
    }
  } else if (col0 < 6656) {
#pragma unroll
    for (int mt = 0; mt < 4; ++mt)
#pragma unroll
      for (int nt = 0; nt < 4; ++nt)
#pragma unroll
        for (int j = 0; j < 4; ++j) __builtin_nontemporal_store(f2bf(silu_f(acc[mt][nt][j])), &p.za[(size_t)(rbase + mt * 16 + q * 4 + j) * 1024 + (col0 - 5632) + nt * 16 + l15]);
  } else if (col0 < 6720) {
    const float dtb = p.dt_bias[l15];
#pragma unroll
    for (int mt = 0; mt < 4; ++mt)
#pragma unroll
      for (int j = 0; j < 4; ++j) {
        const int row = rbase + mt * 16 + q * 4 + j;
#pragma unroll
        for (int nt = 0; nt < 3; ++nt) p.gates[(size_t)row * 48 + nt * 16 + l15] = sigmoid_f(acc[mt][nt][j]);
        p.dtv[(size_t)row * 16 + l15] = softplus_f(acc[mt][3][j] + dtb);
      }
  }
}

DI void gemm1_mini_tile(const Params& p, int mt_i, unsigned char* smem) {
  const int m0 = mt_i * 64;
  f32x4 acc[2][2]; zero_acc(acc);
  gemm_core<2, 2>(p.hbf + (size_t)m0 * LDH, LDH, p.wt + (size_t)6656 * LDH, LDH, DM, acc, (u16*)smem);
  const int tid = otid(), lane = tid & 63, wave = tid >> 6, wm = wave >> 1, wn = wave & 1, l15 = lane & 15, q = lane >> 4;
  const float dtb = p.dt_bias[l15];
#pragma unroll
  for (int mt = 0; mt < 2; ++mt)
#pragma unroll
    for (int j = 0; j < 4; ++j) {
      const int row = m0 + wm * 32 + mt * 16 + q * 4 + j;
      if (wn == 0) {
        p.gates[(size_t)row * 48 + l15] = sigmoid_f(acc[mt][0][j]);
        p.gates[(size_t)row * 48 + 16 + l15] = sigmoid_f(acc[mt][1][j]);
      } else {
        p.gates[(size_t)row * 48 + 32 + l15] = sigmoid_f(acc[mt][0][j]);
        p.dtv[(size_t)row * 16 + l15] = softplus_f(acc[mt][1][j] + dtb);
      }
    }
}

DI void unpack8(const U4& v, float (&f)[8]) {
  f[0] = lo_f(v.x); f[1] = hi_f(v.x); f[2] = lo_f(v.y); f[3] = hi_f(v.y); f[4] = lo_f(v.z); f[5] = hi_f(v.z); f[6] = lo_f(v.w); f[7] = hi_f(v.w);
}
template <int NCH, int RPS>
DI void conv_fetch(const Params& p, U4 (&u)[RPS + 3], int grow0, int t0, int ch0) {
  constexpr int NCG = NCH / 8;
  const int tid = otid(); const int cgi = tid % NCG, seg = tid / NCG;
  int ch = ch0 + cgi * 8;
  asm volatile("" : "+v"(ch));
  const u16* src = p.xbc + (size_t)grow0 * 2048 + ch;
  const int r0 = seg * RPS;
#pragma unroll
  for (int k = 0; k < RPS; ++k) u[k + 3] = *(const U4*)(src + (r0 + k) * 2048);
}
template <int NCH, int RPS>
DI void conv_apply(const Params& p, const U4 (&u)[RPS + 3], u16* dst, int dstride, int ch0, const float* rscale) {
  constexpr int NCG = NCH / 8;
  const int tid = otid(); const int cgi = tid % NCG, seg = tid / NCG;
  const int r0 = seg * RPS;
#pragma unroll
  for (int k = 0; k < RPS; ++k) {
    U4 v = u[k + 3];
    if (rscale) {
      float f0[8]; unpack8(v, f0);
      const float sc = rscale[r0 + k];
      v = U4{pack2(f0[0] * sc, f0[1] * sc), pack2(f0[2] * sc, f0[3] * sc), pack2(f0[4] * sc, f0[5] * sc), pack2(f0[6] * sc, f0[7] * sc)};
    }
    *(U4*)(dst + (r0 + k) * dstride + cgi * 8) = v;
  }
}
template <int NCH, int RPS>
DI void conv_load(const Params& p, u16* dst, int dstride, int grow0, int t0, int ch0, const float* rscale) {
  U4 u[RPS + 3];
  conv_fetch<NCH, RPS>(p, u, grow0, t0, ch0);
  conv_apply<NCH, RPS>(p, u, dst, dstride, ch0, rscale);
}

DI void preconv_item(const Params& p, int item) {
  const int tid = otid();
  const int slab = item >> 1, chalf = item & 1;
  const int cgi = tid & 127, rh = tid >> 7;
  const int ch = chalf * 1024 + cgi * 8;
  const int r0 = slab * 64 + rh * 32;
  float w0[8], w1[8], w2[8], w3[8], bs[8];
#pragma unroll
  for (int h = 0; h < 2; ++h) {
    const float4 a0 = *(const float4*)(p.conv_w + 0 * 2048 + ch + h * 4), a1 = *(const float4*)(p.conv_w + 1 * 2048 + ch + h * 4);
    const float4 a2 = *(const float4*)(p.conv_w + 2 * 2048 + ch + h * 4), a3 = *(const float4*)(p.conv_w + 3 * 2048 + ch + h * 4);
    const float4 bb = *(const float4*)(p.conv_b + ch + h * 4);
    w0[h * 4 + 0] = a0.x; w0[h * 4 + 1] = a0.y; w0[h * 4 + 2] = a0.z; w0[h * 4 + 3] = a0.w;
    w1[h * 4 + 0] = a1.x; w1[h * 4 + 1] = a1.y; w1[h * 4 + 2] = a1.z; w1[h * 4 + 3] = a1.w;
    w2[h * 4 + 0] = a2.x; w2[h * 4 + 1] = a2.y; w2[h * 4 + 2] = a2.z; w2[h * 4 + 3] = a2.w;
    w3[h * 4 + 0] = a3.x; w3[h * 4 + 1] = a3.y; w3[h * 4 + 2] = a3.z; w3[h * 4 + 3] = a3.w;
    bs[h * 4 + 0] = bb.x; bs[h * 4 + 1] = bb.y; bs[h * 4 + 2] = bb.z; bs[h * 4 + 3] = bb.w;
  }
  u16* xb = p.xbc + (size_t)r0 * 2048 + ch;
  const U4 z4 = U4{0u, 0u, 0u, 0u};
  U4 um3, um2, um1;
  if (rh == 1) {
    um3 = *(const U4*)(xb - 3 * 2048); um2 = *(const U4*)(xb - 2 * 2048); um1 = *(const U4*)(xb - 1 * 2048);
  } else if ((r0 & (SEQ - 1)) == 0) {
    um3 = z4; um2 = z4; um1 = z4;
  } else {
    const u16* hp = (const u16*)p.states + (size_t)((slab - 1) * 3) * 2048 + ch;
    um3 = *(const U4*)hp; um2 = *(const U4*)(hp + 2048); um1 = *(const U4*)(hp + 4096);
  }
  __syncthreads();
#pragma unroll 1
  for (int rb8 = 0; rb8 < 32; rb8 += 8) {
    U4 u[8];
#pragma unroll
    for (int k = 0; k < 8; ++k) u[k] = *(const U4*)(xb + (rb8 + k) * 2048);
#pragma unroll
    for (int k = 0; k < 8; ++k) {
      float f3[8], f2[8], f1[8], f0[8], o[8];
      unpack8(um3, f3); unpack8(um2, f2); unpack8(um1, f1); unpack8(u[k], f0);
#pragma unroll
      for (int e = 0; e < 8; ++e) o[e] = silu_f(bs[e] + w0[e] * f3[e] + w1[e] * f2[e] + w2[e] * f1[e] + w3[e] * f0[e]);
      *(U4*)(xb + (rb8 + k) * 2048) = U4{pack2(o[0], o[1]), pack2(o[2], o[3]), pack2(o[4], o[5]), pack2(o[6], o[7])};
      um3 = um2; um2 = um1; um1 = u[k];
    }
  }
}

DI float block_scan256(float v, float* tmp  ) {
  const int lane = threadIdx.x & 63, wave = threadIdx.x >> 6;
#pragma unroll
  for (int o = 1; o < 64; o <<= 1) { const float t = __shfl_up(v, o, 64); if (lane >= o) v += t; }
  if (lane == 63) tmp[wave] = v;
  __syncthreads();
  float add = 0.f;
  if (wave > 0) add += tmp[0];
  if (wave > 1) add += tmp[1];
  if (wave > 2) add += tmp[2];
  return v + add;
}
DI void scan256(float* a) {
  const int tid = otid();
  for (int off = 1; off < 256; off <<= 1) {
    const float t = (tid >= off) ? a[tid - off] : 0.f;
    __syncthreads();
    a[tid] += t;
    __syncthreads();
  }
}

DI void ssd_states_item(const Params& p, int item, unsigned char* smem) {
  const int tid = otid(), lane = tid & 63, wave = tid >> 6, l15 = lane & 15, q = lane >> 4;
  const int b = item >> 9, c = (item >> 4) & 31, h = item & 15, g = h >> 2;
  float* acs = (float*)smem; float* wsc = acs + 256;
  u16* Xs = (u16*)(smem + 2048); u16* Bs = Xs + 128 * 72;
  const int rb = b * SEQ + c * 256;
  const float A_h = -expf(p.a_log[h]);
  const float dtl = p.dtv[(size_t)(rb + tid) * 16 + h];
  __syncthreads();
  acs[tid] = block_scan256(dtl * A_h, (float*)(smem + 65536 + 16));
  __syncthreads();
  const float tot = acs[255];
  wsc[tid] = __expf(tot - acs[tid]) * dtl;
  if (tid == 255) p.cd[(b * 32 + c) * 16 + h] = __expf(tot);
  f32x4 acc[4][2]; zero_acc(acc);
  for (int half = 0; half < 2; ++half) {
    __syncthreads();
    {
      U4 ux[7], ub[11];
      conv_fetch<64, 4>(p, ux, rb + half * 128, c * 256 + half * 128, h * 64);
      conv_fetch<128, 8>(p, ub, rb + half * 128, c * 256 + half * 128, 1024 + g * 128);
      conv_apply<64, 4>(p, ux, Xs, 72, h * 64, wsc + half * 128);
      conv_apply<128, 8>(p, ub, Bs, 136, 1024 + g * 128, nullptr);
    }
    __syncthreads();
#pragma unroll
    for (int ks = 0; ks < 4; ++ks) {
      bf16x8 af[4], bfr[2];
#pragma unroll
      for (int pt = 0; pt < 4; ++pt) {
        const u16* s = Xs + (ks * 32 + q * 8 + (l15 >> 2)) * 72 + pt * 16 + (l15 & 3) * 4;
        af[pt] = tr_frag(s, s + 4 * 72);
      }
#pragma unroll
      for (int nt = 0; nt < 2; ++nt) {
        const u16* s = Bs + (ks * 32 + q * 8 + (l15 >> 2)) * 136 + (wave * 2 + nt) * 16 + (l15 & 3) * 4;
        bfr[nt] = tr_frag(s, s + 4 * 136);
      }
#pragma unroll
      for (int pt = 0; pt < 4; ++pt)
#pragma unroll
        for (int nt = 0; nt < 2; ++nt) acc[pt][nt] = mfma16(af[pt], bfr[nt], acc[pt][nt]);
    }
  }
  float* st = p.states + (size_t)item * 8192;
#pragma unroll
  for (int pt = 0; pt < 4; ++pt)
#pragma unroll
    for (int nt = 0; nt < 2; ++nt)
#pragma unroll
      for (int j = 0; j < 4; ++j) st[(pt * 16 + q * 4 + j) * 128 + (wave * 2 + nt) * 16 + l15] = acc[pt][nt][j];
}

DI void cmp_a_tile(const Params& p, int tile, unsigned char* smem) {
  const int which = tile >> 7, r = tile & 127; const int bg = r >> 4, mt_i = (r >> 1) & 7, nt_i = r & 1;
  const u16* A = (which ? p.vcmp : p.kcmp) + (size_t)bg * SEQ * 64 + (size_t)(mt_i * 64) * 1024;
  const u16* Bt = (which ? p.w1v_t : p.w1k_t) + (size_t)(nt_i * 128) * 2048;
  f32x4 acc[2][4]; zero_acc(acc);
  gemm_core<2, 4>(A, 1024, Bt, 2048, 2048, acc, (u16*)smem);
  const int tid = otid(), lane = tid & 63, wave = tid >> 6, wm = wave >> 1, wn = wave & 1, l15 = lane & 15, q = lane >> 4;
  u16* hid = which ? p.hid_v : p.hid_k;
#pragma unroll
  for (int nt = 0; nt < 4; ++nt) {
    const int col = nt_i * 128 + wn * 64 + nt * 16 + l15;
    float bias = (which ? p.cv_b1 : p.ck_b1)[col];
    for (int c = 0; c < 32; ++c) bias += p.peb[(which * 32 + c) * 256 + col];
#pragma unroll
    for (int mt = 0; mt < 2; ++mt)
#pragma unroll
      for (int j = 0; j < 4; ++j) {
        const int row = bg * 512 + mt_i * 64 + wm * 32 + mt * 16 + q * 4 + j;
        hid[(size_t)row * 256 + col] = f2bf(gelu_tanh(acc[mt][nt][j] + bias));
      }
  }
}

DI void scan_item(const Params& p, int item) {
  const int e4 = item * 256 + threadIdx.x;
  const int b = e4 >> 15, h = (e4 >> 11) & 15, r = e4 & 2047;
  float4* st = (float4*)p.states;
  float4 carry = make_float4(0.f, 0.f, 0.f, 0.f);
#pragma unroll 1
  for (int c0 = 0; c0 < 32; c0 += 16) {
    float4 sv[16]; float dv[16];
#pragma unroll
    for (int k = 0; k < 16; ++k) { sv[k] = st[(size_t)((b * 32 + c0 + k) * 16 + h) * 2048 + r]; dv[k] = p.cd[(b * 32 + c0 + k) * 16 + h]; }
#pragma unroll
    for (int k = 0; k < 16; ++k) {
      st[(size_t)((b * 32 + c0 + k) * 16 + h) * 2048 + r] = carry;
      carry.x = dv[k] * carry.x + sv[k].x; carry.y = dv[k] * carry.y + sv[k].y; carry.z = dv[k] * carry.z + sv[k].z; carry.w = dv[k] * carry.w + sv[k].w;
    }
  }
}

DI void cmp_b_tile(const Params& p, int tile, unsigned char* smem) {
  const int which = tile >> 5, mt_i = tile & 31;
  f32x4 acc[4][2]; zero_acc(acc);
  gemm_core<4, 2>((which ? p.hid_v : p.hid_k) + (size_t)(mt_i * 128) * 256, 256, which ? p.w2v_t : p.w2k_t, 256, 256, acc, (u16*)smem);
  const int tid = otid(), lane = tid & 63, wave = tid >> 6, wm = wave >> 1, wn = wave & 1, l15 = lane & 15, q = lane >> 4;
#pragma unroll
  for (int mt = 0; mt < 4; ++mt)
#pragma unroll
    for (int nt = 0; nt < 2; ++nt) {
      const int row0 = mt_i * 128 + wm * 64 + mt * 16 + q * 4; const int col = wn * 32 + nt * 16 + l15;
      const int bg = row0 >> 9, i0 = row0 & 511;
      if (which == 0) {
#pragma unroll
        for (int j = 0; j < 4; ++j) p.kc[(size_t)(row0 + j) * 64 + col] = (i0 + j == 511) ? (u16)0 : f2bf(acc[mt][nt][j]);
      } else {
        U2 o; o.x = pack2(acc[mt][nt][0], acc[mt][nt][1]); o.y = pack2(acc[mt][nt][2], (i0 + 3 == 511) ? 0.f : acc[mt][nt][3]);
        *(U2*)(p.vcT + (size_t)(bg * 64 + col) * 512 + i0) = o;
      }
    }
}

DI void ssd_y_item(const Params& p, int item, unsigned char* smem, int rep) {
  const int tid = otid(), lane = tid & 63, wave = tid >> 6, l15 = lane & 15, q = lane >> 4;
  const int b = item >> 9, c = (item >> 4) & 31, h = item & 15, g = h >> 2;
  float* acs = (float*)smem; float* dts = acs + 256;
  u16* R1 = (u16*)(smem + 2048);
  u16* Ps = (u16*)(smem + 2048 + 34816);
  u16* Bts = R1; u16* Xts = R1 + 64 * 136;
  const int rb = b * SEQ + c * 256;
  const float A_h = -expf(p.a_log[h]);
  const float Dh = p.d_skip[h];
  const float dtl = p.dtv[(size_t)(rb + tid) * 16 + h];
  __syncthreads();
  acs[tid] = block_scan256(dtl * A_h, (float*)(smem + 65536 + 16)); dts[tid] = dtl;
  __syncthreads();
  {
    const float4* st = (const float4*)(p.states + (size_t)item * 8192);
#pragma unroll
    for (int i = 0; i < 8; ++i) {
      const int idx = tid + i * 256; const float4 v = st[idx];
      U2 o; o.x = pack2(v.x, v.y); o.y = pack2(v.z, v.w);
      *(U2*)(Ps + (idx >> 5) * 136 + (idx & 31) * 4) = o;
    }
  }
  for (int lh = 0; lh < 2; ++lh) {
    __syncthreads();
    conv_load<128, 8>(p, R1, 136, rb + lh * 128, c * 256 + lh * 128, 1536 + g * 128, nullptr);
    __syncthreads();
    bf16x8 Cf[2][4]; int lrow[2]; float acl[2];
#pragma unroll
    for (int nt = 0; nt < 2; ++nt) {
      lrow[nt] = lh * 128 + wave * 32 + nt * 16 + l15; acl[nt] = acs[lrow[nt]];
#pragma unroll
      for (int ks = 0; ks < 4; ++ks) Cf[nt][ks] = *(const bf16x8*)(R1 + (wave * 32 + nt * 16 + l15) * 136 + ks * 32 + q * 8);
    }
    f32x4 O[4][2]; zero_acc(O);
#pragma unroll
    for (int dt = 0; dt < 4; ++dt)
#pragma unroll
      for (int ks = 0; ks < 4; ++ks) {
        const bf16x8 a = *(const bf16x8*)(Ps + (dt * 16 + l15) * 136 + ks * 32 + q * 8);
#pragma unroll
        for (int nt = 0; nt < 2; ++nt) O[dt][nt] = mfma16(a, Cf[nt][ks], O[dt][nt]);
      }
#pragma unroll
    for (int nt = 0; nt < 2; ++nt) {
      const float e = __expf(acl[nt]);
#pragma unroll
      for (int dt = 0; dt < 4; ++dt) O[dt][nt] *= e;
    }
    const int nsb = lh * 2 + 2;
    for (int sb = 0; sb < nsb; ++sb) {
      __syncthreads();
      {
        U4 ub[7], ux[5];
        conv_fetch<128, 4>(p, ub, rb + sb * 64, c * 256 + sb * 64, 1024 + g * 128);
        conv_fetch<64, 2>(p, ux, rb + sb * 64, c * 256 + sb * 64, h * 64);
        conv_apply<128, 4>(p, ub, Bts, 136, 1024 + g * 128, nullptr);
        conv_apply<64, 2>(p, ux, Xts, 72, h * 64, nullptr);
      }
      __syncthreads();
      if (sb * 64 <= lh * 128 + wave * 32 + 31) {
#pragma unroll 1
        for (int kp = 0; kp < 2; ++kp) {
          f32x4 S[2][2]; zero_acc(S);
#pragma unroll
          for (int k2 = 0; k2 < 2; ++k2)
#pragma unroll
            for (int ks = 0; ks < 4; ++ks) {
              const bf16x8 a = *(const bf16x8*)(Bts + (kp * 32 + k2 * 16 + l15) * 136 + ks * 32 + q * 8);
#pragma unroll
              for (int nt = 0; nt < 2; ++nt) S[k2][nt] = mfma16(a, Cf[nt][ks], S[k2][nt]);
            }
#pragma unroll
          for (int k2 = 0; k2 < 2; ++k2) {
            const int s0 = sb * 64 + kp * 32 + k2 * 16 + q * 4;
            const float4 as4 = *(const float4*)(acs + s0); const float4 dt4 = *(const float4*)(dts + s0);
            const float asv[4] = {as4.x, as4.y, as4.z, as4.w}; const float dtv4[4] = {dt4.x, dt4.y, dt4.z, dt4.w};
#pragma unroll
            for (int nt = 0; nt < 2; ++nt)
#pragma unroll
              for (int j = 0; j < 4; ++j) {
                const int sidx = s0 + j;
                float v = (sidx <= lrow[nt]) ? S[k2][nt][j] * __expf(acl[nt] - asv[j]) * dtv4[j] : 0.f;
                if (sidx == lrow[nt]) v += Dh;
                S[k2][nt][j] = v;
              }
          }
          bf16x8 P[2];
#pragma unroll
          for (int nt = 0; nt < 2; ++nt)
            P[nt] = as_bf16x8(pack2(S[0][nt][0], S[0][nt][1]), pack2(S[0][nt][2], S[0][nt][3]), pack2(S[1][nt][0], S[1][nt][1]), pack2(S[1][nt][2], S[1][nt][3]));
#pragma unroll
          for (int dt = 0; dt < 4; ++dt) {
            const u16* sx = Xts + (kp * 32 + q * 4 + (l15 >> 2)) * 72 + dt * 16 + (l15 & 3) * 4;
            const bf16x8 a = tr_frag(sx, sx + 16 * 72);
#pragma unroll
            for (int nt = 0; nt < 2; ++nt) O[dt][nt] = mfma16(a, P[nt], O[dt][nt]);
          }
        }
      }
    }
#pragma unroll
    for (int nt = 0; nt < 2; ++nt) {
      const size_t rowoff = (size_t)(rb + lrow[nt]) * 1024 + h * 64;
      float ss = 0.f;
#pragma unroll
      for (int dt = 0; dt < 4; ++dt) {
        u16* zp = p.zs + rowoff + dt * 16 + q * 4;
        const U2 zv = *(const U2*)zp;
        const float v0 = O[dt][nt][0] * lo_f(zv.x), v1 = O[dt][nt][1] * hi_f(zv.x), v2 = O[dt][nt][2] * lo_f(zv.y), v3 = O[dt][nt][3] * hi_f(zv.y);
        ss += v0 * v0 + v1 * v1 + v2 * v2 + v3 * v3;
        U2 o; o.x = pack2(v0, v1); o.y = pack2(v2, v3);
        if (rep) *(U2*)zp = o;
      }
      ss += __shfl_xor(ss, 16, 64); ss += __shfl_xor(ss, 32, 64);
      if (q == 0 && rep) p.ssq[(size_t)(rb + lrow[nt]) * 16 + h] = ss;
    }
  }
}

template <int MODE>
DI void attn_pass(unsigned char* smem, const u16* Kg, const u16* VTg, int ldv, int jb0, int jb1, u64 act0, u64 act1,
                  const bf16x8 (&Qf)[4][2], float (&m)[4], float (&ls)[4], f32x4 (&O)[4][4],
                  const int (&lo)[4], const int (&hi)[4], const u64* selrow  ,
                  const float (&invL)[4], float* imp_row  ) {
  u16* Ks = (u16*)smem; u16* Vs = Ks + 64 * 72;
  const int tid = otid(), lane = tid & 63, l15 = lane & 15, q = lane >> 4;
  U4 rk[2], rv[2];
  int jb = jb0;
  while (jb <= jb1 && !(((jb < 64 ? (act0 >> jb) : (act1 >> (jb - 64))) & 1ull))) ++jb;
  if (jb > jb1) return;
#pragma unroll
  for (int i = 0; i < 2; ++i) {
    const int ci = tid + i * 256; const int row = ci >> 3, cc = ci & 7;
    rk[i] = *(const U4*)(Kg + (size_t)(jb * 64 + row) * 64 + cc * 8);
    if (MODE != 1) rv[i] = *(const U4*)(VTg + (size_t)row * ldv + jb * 64 + cc * 8);
  }
  float carry[4] = {0.f, 0.f, 0.f, 0.f};
  while (jb <= jb1) {
    __syncthreads();
#pragma unroll
    for (int i = 0; i < 2; ++i) {
      const int ci = tid + i * 256; const int row = ci >> 3, cc = ci & 7;
      *(U4*)(Ks + row * 72 + cc * 8) = rk[i];
      if (MODE != 1) *(U4*)(Vs + row * 72 + cc * 8) = rv[i];
    }
    __syncthreads();
    int nj = jb + 1;
    while (nj <= jb1 && !(((nj < 64 ? (act0 >> nj) : (act1 >> (nj - 64))) & 1ull))) ++nj;
    if (nj <= jb1) {
#pragma unroll
      for (int i = 0; i < 2; ++i) {
        const int ci = tid + i * 256; const int row = ci >> 3, cc = ci & 7;
        rk[i] = *(const U4*)(Kg + (size_t)(nj * 64 + row) * 64 + cc * 8);
        if (MODE != 1) rv[i] = *(const U4*)(VTg + (size_t)row * ldv + nj * 64 + cc * 8);
      }
    }
    bool rowok[4]; unsigned need = 0u; bool allin = true;
#pragma unroll
    for (int nt = 0; nt < 4; ++nt) {
      rowok[nt] = selrow ? (((selrow[nt * 8 + (jb >> 6)] >> (jb & 63)) & 1ull) != 0) : true;
      if (__ballot(rowok[nt]) != 0ull) need |= 1u << nt;
      allin = allin && (lo[nt] <= jb * 64) && (jb * 64 + 63 <= hi[nt]);
    }
    const bool interior = (__ballot(!allin) == 0ull);
    if (need != 0u) {
#pragma unroll 1
    for (int half = 0; half < 2; ++half) {
      const int kbase = jb * 64 + half * 32;
      bf16x8 ka[2][2], va[4];
#pragma unroll
      for (int kt2 = 0; kt2 < 2; ++kt2) {
        const u16* kr = Ks + (half * 32 + kt2 * 16 + l15) * 72 + q * 8;
        ka[kt2][0] = *(const bf16x8*)kr; ka[kt2][1] = *(const bf16x8*)(kr + 32);
      }
      if (MODE != 1) {
#pragma unroll
        for (int dt = 0; dt < 4; ++dt) {
          const u16* vr = Vs + (dt * 16 + l15) * 72 + half * 32 + q * 4;
          const U2 v0 = *(const U2*)vr; const U2 v1 = *(const U2*)(vr + 16);
          va[dt] = as_bf16x8(v0.x, v0.y, v1.x, v1.y);
        }
      }
#pragma unroll
      for (int nt = 0; nt < 4; ++nt) {
        if (need & (1u << nt)) {
          f32x4 S[2];
#pragma unroll
          for (int kt2 = 0; kt2 < 2; ++kt2) {
            S[kt2] = mfma16(ka[kt2][0], Qf[nt][0], f32x4{0.f, 0.f, 0.f, 0.f});
            S[kt2] = mfma16(ka[kt2][1], Qf[nt][1], S[kt2]);
          }
          if (!interior) {
#pragma unroll
            for (int kt2 = 0; kt2 < 2; ++kt2)
#pragma unroll
              for (int j = 0; j < 4; ++j) {
                const int kp = kbase + kt2 * 16 + q * 4 + j;
                S[kt2][j] = (kp >= lo[nt] && kp <= hi[nt]) ? S[kt2][j] : -__builtin_inff();
              }
          }
          if (MODE != 2) {
            float ml;
            {
              const float r1 = max3_f(S[0][0], S[0][1], S[0][2]), r2 = max3_f(S[0][3], S[1][0], S[1][1]), r3 = max3_f(S[1][2], S[1][3], S[1][3]);
              ml = max3_f(r1, r2, r3);
            }
            ml = rowok[nt] ? ml : -__builtin_inff();
            if (__ballot(ml > m[nt] + 8.f) != 0ull) {
              const float mx = quad_max(max3_f(ml, m[nt], m[nt]));
              const float alpha = exp2_f(m[nt] - mx);
              m[nt] = mx;
              ls[nt] *= alpha;
              if (MODE == 0) {
#pragma unroll
                for (int dt = 0; dt < 4; ++dt) O[dt][nt] *= alpha;
              }
            }
            const float neg = rowok[nt] ? m[nt] : __builtin_inff();
#pragma unroll
            for (int kt2 = 0; kt2 < 2; ++kt2)
#pragma unroll
              for (int j = 0; j < 4; ++j) S[kt2][j] = exp2_f(S[kt2][j] - neg);
            ls[nt] += ((S[0][0] + S[0][1]) + (S[0][2] + S[0][3])) + ((S[1][0] + S[1][1]) + (S[1][2] + S[1][3]));
          } else {
            float own = 0.f;
#pragma unroll
            for (int kt2 = 0; kt2 < 2; ++kt2)
#pragma unroll
              for (int j = 0; j < 4; ++j) S[kt2][j] = exp2_f(S[kt2][j] - m[nt]) * invL[nt];
#pragma unroll
            for (int kt2 = 0; kt2 < 2; ++kt2) {
              own = (S[kt2][0] + S[kt2][1]) + (S[kt2][2] + S[kt2][3]);
              float last = S[kt2][3];
              own += __shfl_xor(own, 1, 64); own += __shfl_xor(own, 2, 64);
              last += __shfl_xor(last, 1, 64); last += __shfl_xor(last, 2, 64);
              const float up = __shfl(last, (lane + 48) & 63, 64);
              const float nb = (q > 0) ? up : carry[nt];
              carry[nt] = up;
              if ((l15 & 3) == 0) imp_row[nt * 512 + ((kbase + kt2 * 16) >> 2) + q] = own + nb;
            }
          }
          if (MODE != 1) {
            const bf16x8 P = as_bf16x8(pack2(S[0][0], S[0][1]), pack2(S[0][2], S[0][3]), pack2(S[1][0], S[1][1]), pack2(S[1][2], S[1][3]));
#pragma unroll
            for (int dt = 0; dt < 4; ++dt) O[dt][nt] = mfma16(va[dt], P, O[dt][nt]);
          }
        }
      }
    }
    }
    jb = nj;
  }
}

DI void accum_lds(unsigned* otl, const f32x4 (&O)[4][4], const float (&sc)[4], bool first) {
  const int lane = threadIdx.x & 63;
#pragma unroll
  for (int dt = 0; dt < 4; ++dt)
#pragma unroll
    for (int nt = 0; nt < 4; ++nt) {
      float v0 = O[dt][nt][0] * sc[nt], v1 = O[dt][nt][1] * sc[nt], v2 = O[dt][nt][2] * sc[nt], v3 = O[dt][nt][3] * sc[nt];
      unsigned* a = otl + ((dt * 4 + nt) * 2) * 64 + lane;
      if (!first) { const unsigned p0 = a[0], p1 = a[64]; v0 += lo_f(p0); v1 += hi_f(p0); v2 += lo_f(p1); v3 += hi_f(p1); }
      a[0] = pack2(v0, v1); a[64] = pack2(v2, v3);
    }
}

DI void attn_item(const Params& p, int cur, int bg, unsigned char* smem, int rep) {
  const int tid = otid(), lane = tid & 63, wave = tid >> 6, l15 = lane & 15, q = lane >> 4;
  const int b = bg >> 2, g = bg & 3;
  const int tl = l15 >> 2, hd = l15 & 3;
  float* imp = (float*)(smem + 18432);
  u64* sel = (u64*)(smem + 18432 + 32768);
  u64* uni = sel + 128;
  const int tokl0 = wave * 16 + tl;
  const int t0 = cur * 64 + tokl0;
  const size_t row0 = (size_t)b * SEQ + t0;
  bf16x8 Qf[4][2];
#pragma unroll
  for (int nt = 0; nt < 4; ++nt)
#pragma unroll
    for (int ks = 0; ks < 2; ++ks) Qf[nt][ks] = *(const bf16x8*)(p.q + (row0 + nt * 4) * 1024 + (g * 4 + hd) * 64 + ks * 32 + q * 8);
  float m[4], ls[4], invL[4], sc[4]; f32x4 O[4][4];
  int lo[4], hi[4];
  unsigned* otl = (unsigned*)imp + wave * 2048;
  const u64 ALL = ~0ull;
  {
  const u16* kcg = p.kc + (size_t)bg * 512 * 64; const u16* vcg = p.vcT + (size_t)bg * 64 * 512;
  const int nkb = ((4 * cur + 2) >> 6) + 1;
#pragma unroll
  for (int nt = 0; nt < 4; ++nt) { m[nt] = -1e30f; ls[nt] = 0.f; invL[nt] = 0.f; lo[nt] = 0; hi[nt] = (t0 + nt * 4 - 31) >> 4; }
  zero_acc(O);
  attn_pass<1>(smem, kcg, vcg, 512, 0, nkb - 1, ALL, ALL, Qf, m, ls, O, lo, hi, nullptr, invL, nullptr);
#pragma unroll
  for (int nt = 0; nt < 4; ++nt) {
    const float L = quad_sum(ls[nt]);
    invL[nt] = (L > 0.f) ? 1.f / L : 0.f;
  }
  attn_pass<2>(smem, kcg, vcg, 512, 0, nkb - 1, ALL, ALL, Qf, m, ls, O, lo, hi, nullptr, invL, imp + tokl0 * 128);
#pragma unroll
  for (int nt = 0; nt < 4; ++nt) sc[nt] = p.gates[(row0 + nt * 4) * 48 + (g * 4 + hd) * 3 + 0];
  __syncthreads();
  {
    u64 un0 = 0, un1 = 0;
    const u64 v0m = (cur >= 63) ? ALL : ((1ull << (cur + 1)) - 1ull);
    const u64 v1m = (cur < 64) ? 0ull : ((cur >= 127) ? ALL : ((1ull << (cur - 63)) - 1ull));
    const u64 lowm = (1ull << lane) - 1ull;
    for (int tk = 0; tk < 16; ++tk) {
      const float* rowp = imp + (wave * 16 + tk) * 128;
      const int j0 = lane, j1 = lane + 64;
      unsigned k0 = 0u, k1 = 0u;
      if (j0 <= cur) k0 = (j0 == 0 || j0 == cur || j0 == cur - 1) ? 0x7F800000u : __float_as_uint(rowp[j0]);
      if (j1 <= cur) k1 = (j1 == cur || j1 == cur - 1) ? 0x7F800000u : __float_as_uint(rowp[j1]);
      unsigned T = 0u;
      for (int bit = 30; bit >= 0; --bit) {
        const unsigned cand = T | (1u << bit);
        const int cnt = __popcll(__ballot(k0 >= cand)) + __popcll(__ballot(k1 >= cand));
        if (cnt >= 16) T = cand;
      }
      const u64 gt0 = __ballot(k0 > T), gt1 = __ballot(k1 > T);
      const int needn = 16 - (__popcll(gt0) + __popcll(gt1));
      const u64 eq0 = __ballot(k0 == T), eq1 = __ballot(k1 == T);
      const int r0 = __popcll(eq0 & lowm), r1 = __popcll(eq0) + __popcll(eq1 & lowm);
      const bool s0 = (k0 > T) || (k0 == T && r0 < needn);
      const bool s1 = (k1 > T) || (k1 == T && r1 < needn);
      const u64 b0 = __ballot(s0) & v0m, b1 = __ballot(s1) & v1m;
      if (lane == 0) { sel[(wave * 16 + tk) * 2] = b0; sel[(wave * 16 + tk) * 2 + 1] = b1; }
      un0 |= b0; un1 |= b1;
    }
    if (lane == 0) { uni[wave * 2] = un0; uni[wave * 2 + 1] = un1; }
  }
  accum_lds(otl, O, sc, true);
  __syncthreads();
  const u64 act0 = uni[0] | uni[2] | uni[4] | uni[6], act1 = uni[1] | uni[3] | uni[5] | uni[7];
#pragma unroll
  for (int nt = 0; nt < 4; ++nt) { m[nt] = -1e30f; ls[nt] = 0.f; lo[nt] = 0; hi[nt] = t0 + nt * 4; }
  zero_acc(O);
  attn_pass<0>(smem, p.kslc + (size_t)bg * SEQ * 64, p.vslcT + (size_t)bg * 64 * SEQ, SEQ, 0, cur, act0, act1, Qf, m, ls, O, lo, hi, sel + tokl0 * 2, invL, nullptr);
#pragma unroll
  for (int nt = 0; nt < 4; ++nt) {
    const float L = quad_sum(ls[nt]);
    sc[nt] = (L > 0.f) ? p.gates[(row0 + nt * 4) * 48 + (g * 4 + hd) * 3 + 1] / L : 0.f;
  }
  accum_lds(otl, O, sc, false);
#pragma unroll
  for (int nt = 0; nt < 4; ++nt) { m[nt] = -1e30f; ls[nt] = 0.f; lo[nt] = t0 + nt * 4 - 511; hi[nt] = t0 + nt * 4; }
  zero_acc(O);
  attn_pass<0>(smem, p.kwin + (size_t)bg * SEQ * 64, p.vwinT + (size_t)bg * 64 * SEQ, SEQ, (cur >= 8 ? cur - 8 : 0), cur, ALL, ALL, Qf, m, ls, O, lo, hi, nullptr, invL, nullptr);
#pragma unroll
  for (int nt = 0; nt < 4; ++nt) {
    const float L = quad_sum(ls[nt]);
    sc[nt] = (L > 0.f) ? p.gates[(row0 + nt * 4) * 48 + (g * 4 + hd) * 3 + 2] / L : 0.f;
  }
  accum_lds(otl, O, sc, false);
  if (rep == 1)
#pragma unroll
  for (int nt = 0; nt < 4; ++nt)
#pragma unroll
    for (int dt = 0; dt < 4; ++dt) {
      u16* zp = p.za + (row0 + nt * 4) * 1024 + (g * 4 + hd) * 64 + dt * 16 + q * 4;
      const U2 zv = *(const U2*)zp;
      const unsigned* a = otl + ((dt * 4 + nt) * 2) * 64 + lane;
      const unsigned p0 = a[0], p1 = a[64];
      U2 o;
      o.x = pack2(lo_f(p0) * lo_f(zv.x), hi_f(p0) * hi_f(zv.x));
      o.y = pack2(lo_f(p1) * lo_f(zv.y), hi_f(p1) * hi_f(zv.y));
      *(U2*)zp = o;
    }
  }
}

DI void gemm2_tile(const Params& p, int mt_i, int nt_i, unsigned char* smem) {
  const int m0 = mt_i * 128, n0 = nt_i * 128;
  const int tid = otid(), lane = tid & 63, wave = tid >> 6, wm = wave >> 1, wn = wave & 1, l15 = lane & 15, q = lane >> 4;
  float* rinv = (float*)(smem + 65536 + 64);
  __syncthreads();
  if (tid < 128) {
    const float* sp = p.ssq + (size_t)(m0 + tid) * 16;
    float tot = 0.f;
    for (int k = 0; k < 16; ++k) tot += sp[k];
    rinv[tid] = rsqrtf(tot * (1.f / 1024.f) + EPS);
  }
  f32x4 acc[4][4], res[4][4]; unsigned gte[4][4][2];
  zero_acc(res);
#pragma unroll 1
  for (int br = 0; br < 2; ++br) {
    zero_acc(acc);
    gemm_core<4, 4>(p.hbf + (size_t)m0 * LDH, LDH, p.wt + (size_t)(NG1 + br * 1024 + n0) * LDH, LDH, DM, acc, (u16*)smem);
#pragma unroll
    for (int a = 0; a < 4; ++a)
#pragma unroll
      for (int c = 0; c < 4; ++c) {
        gte[a][c][0] = pack2(sigmoid_f(acc[a][c][0]), sigmoid_f(acc[a][c][1]));
        gte[a][c][1] = pack2(sigmoid_f(acc[a][c][2]), sigmoid_f(acc[a][c][3]));
      }
    zero_acc(acc);
    gemm_core<4, 4>((br ? p.za : p.zs) + (size_t)m0 * DM, DM, (br ? p.wba_t : p.wbs_t) + (size_t)n0 * DM, DM, DM, acc, (u16*)smem);
#pragma unroll
    for (int a = 0; a < 4; ++a) {
      float r[4];
#pragma unroll
      for (int j = 0; j < 4; ++j) r[j] = br ? 1.f : rinv[wm * 64 + a * 16 + q * 4 + j];
#pragma unroll
      for (int c = 0; c < 4; ++c) {
        res[a][c][0] += lo_f(gte[a][c][0]) * r[0] * acc[a][c][0];
        res[a][c][1] += hi_f(gte[a][c][0]) * r[1] * acc[a][c][1];
        res[a][c][2] += lo_f(gte[a][c][1]) * r[2] * acc[a][c][2];
        res[a][c][3] += hi_f(gte[a][c][1]) * r[3] * acc[a][c][3];
      }
    }
  }
  u16* mg = p.q;
#pragma unroll
  for (int a = 0; a < 4; ++a)
#pragma unroll
    for (int c = 0; c < 4; ++c)
#pragma unroll
      for (int j = 0; j < 4; ++j) {
        const int row = m0 + wm * 64 + a * 16 + q * 4 + j; const int col = n0 + wn * 64 + c * 16 + l15;
        mg[(size_t)row * DM + col] = f2bf(res[a][c][j]);
      }
}

DI void gemm3_tile(const Params& p, int mt_i, int nt_i, unsigned char* smem) {
  const int m0 = mt_i * 128, n0 = nt_i * 128;
  const int tid = otid(), lane = tid & 63, wave = tid >> 6, wm = wave >> 1, wn = wave & 1, l15 = lane & 15, q = lane >> 4;
  f32x4 acc[4][4]; zero_acc(acc);
  gemm_core<4, 4>(p.q + (size_t)m0 * DM, DM, p.wout_t + (size_t)n0 * DM, DM, DM, acc, (u16*)smem);
#pragma unroll
  for (int mt = 0; mt < 4; ++mt)
#pragma unroll
    for (int j = 0; j < 4; ++j) {
      const int row = m0 + wm * 64 + mt * 16 + q * 4 + j;
      float ss = 0.f;
#pragma unroll
      for (int nt = 0; nt < 4; ++nt) {
        const int col = n0 + wn * 64 + nt * 16 + l15;
        const float v = acc[mt][nt][j] + __builtin_nontemporal_load(&p.x[(size_t)row * DM + col]);
        p.out[(size_t)row * DM + col] = v;
        ss += v * v;
      }
      ss += __shfl_xor(ss, 1, 64); ss += __shfl_xor(ss, 2, 64); ss += __shfl_xor(ss, 4, 64); ss += __shfl_xor(ss, 8, 64);
      if (l15 == 0) p.ssq2[(size_t)row * 16 + nt_i * 2 + wn] = ss;
    }
}

struct BarState { unsigned epoch, myx, nx_wg, n_xcc; };
DI unsigned xcc_id() { return (unsigned)__builtin_amdgcn_s_getreg((3 << 11) | 20) & 0xFu; }
DI void grid_barrier(unsigned* ctl, BarState& st) {
  st.epoch += 1;
  const unsigned epoch = st.epoch;
  __syncthreads();
  if (threadIdx.x < 64) {
    unsigned last = 0u;
    if (threadIdx.x == 0) {
      if (epoch == 1u) {
        __builtin_amdgcn_fence(__ATOMIC_RELEASE, "agent");
        const unsigned v = __hip_atomic_fetch_add(ctl, 1u, __ATOMIC_RELAXED, __HIP_MEMORY_SCOPE_AGENT) + 1u;
        last = (v == gridDim.x) ? 1u : 0u;
      } else {
        const unsigned a = __hip_atomic_fetch_add(ctl + 256 + st.myx * 32, 1u, __ATOMIC_RELAXED, __HIP_MEMORY_SCOPE_AGENT) + 1u;
        if (a == (epoch - 1u) * st.nx_wg) {
          __builtin_amdgcn_fence(__ATOMIC_RELEASE, "agent");
          const unsigned v = __hip_atomic_fetch_add(ctl + 32, 1u, __ATOMIC_RELAXED, __HIP_MEMORY_SCOPE_AGENT) + 1u;
          last = (v == (epoch - 1u) * st.n_xcc) ? 1u : 0u;
        }
      }
    }
    last = (unsigned)__builtin_amdgcn_readfirstlane((int)last);
    if (last) {
      __builtin_amdgcn_fence(__ATOMIC_ACQUIRE, "agent");
      __builtin_amdgcn_fence(__ATOMIC_RELEASE, "agent");
      for (unsigned g = threadIdx.x; g < ((gridDim.x + 7u) >> 3); g += 64u) __hip_atomic_store(ctl + 1008 + g * 32, epoch, __ATOMIC_RELAXED, __HIP_MEMORY_SCOPE_AGENT);
    }
    if (threadIdx.x == 0) {
      unsigned* f = ctl + 1008 + (blockIdx.x >> 3) * 32;
      while (__hip_atomic_load(f, __ATOMIC_RELAXED, __HIP_MEMORY_SCOPE_AGENT) < epoch) __builtin_amdgcn_s_sleep(64);
      __builtin_amdgcn_fence(__ATOMIC_ACQUIRE, "agent");
      if (epoch == 1u) {
        st.nx_wg = __hip_atomic_load(ctl + 768 + st.myx * 8, __ATOMIC_RELAXED, __HIP_MEMORY_SCOPE_AGENT);
        unsigned n = 0u;
        for (int x = 0; x < 16; ++x) n += (__hip_atomic_load(ctl + 768 + x * 8, __ATOMIC_RELAXED, __HIP_MEMORY_SCOPE_AGENT) != 0u) ? 1u : 0u;
        st.n_xcc = n;
      }
    }
  }
  __syncthreads();
}

__global__ void __launch_bounds__(256, 2) hybrid_fwd(Params p) {
  cg::grid_group grid = cg::this_grid();
  extern __shared__ __attribute__((aligned(16))) unsigned char smem[];
  const int tid = threadIdx.x;
  BarState epoch{}; unsigned* bar = p.counter + 16;
  epoch.myx = xcc_id();
  if (tid == 0) __hip_atomic_fetch_add(bar + 768 + epoch.myx * 8, 1u, __ATOMIC_RELAXED, __HIP_MEMORY_SCOPE_AGENT);
  if (p.counter == nullptr) grid.sync();
  grid_barrier(bar, epoch);
  phase0(p, smem);
#ifdef PROBE_P0X2
  phase0(p, smem);
#endif
  grid_barrier(bar, epoch);
  patch_walk<16, 4>(128, 52, [&](int mt, int nt) { gemm1_tile(p, mt, nt, smem); });
  for (int t = blockIdx.x; t < 256; t += gridDim.x) gemm1_mini_tile(p, t, smem);
#ifdef PROBE_G1X2
  patch_walk(128, 53, [&](int mt, int nt) { gemm1_tile(p, mt, nt, smem); });
#endif
  grid_barrier(bar, epoch);
  for (int t = blockIdx.x; t < 512; t += gridDim.x) preconv_item(p, t);
  grid_barrier(bar, epoch);
  {
    int* s_item = (int*)(smem + 65536);
    for (;;) {
      __syncthreads();
      if (tid == 0) *s_item = (int)atomicAdd(p.counter + 9, 1u);
      __syncthreads();
      const int t = *s_item;
      if (t >= 256 + 1024) break;
      if (t < 256) cmp_a_tile(p, t, smem); else ssd_states_item(p, t - 256, smem);
    }
  }
  grid_barrier(bar, epoch);
#ifdef PROBE_P37X2
  for (int t = blockIdx.x; t < 64 + 256; t += gridDim.x) {
    if (t < 64) cmp_b_tile(p, t, smem);
    else {
      const int e4 = (t - 64) * 256 + threadIdx.x; const int b = e4 >> 15, h = (e4 >> 11) & 15, r = e4 & 2047;
      float4* st = (float4*)p.states;
      for (int c = 0; c < 32; ++c) { const size_t idx = (size_t)((b * 32 + c) * 16 + h) * 2048 + r; float4 v = st[idx]; v.x += 0.f; st[idx] = v; }
    }
  }
#endif
  for (int t = blockIdx.x; t < 64 + 256; t += gridDim.x) { if (t < 64) cmp_b_tile(p, t, smem); else scan_item(p, t - 64); }
  grid_barrier(bar, epoch);
  {
    int* s_item = (int*)(smem + 65536);
#ifndef SKIP_ATTN
    for (;;) {
      __syncthreads();
      if (tid == 0) *s_item = (int)atomicAdd(p.counter + (blockIdx.x & 7), 1u);
      __syncthreads();
      const int item = *s_item;
#ifdef PROBE_ATTNX2
      if (item >= 256) break;
      attn_item(p, 127 - (item >> 1), blockIdx.x & 7, smem, item & 1);
#else
      if (item >= 128) break;
      attn_item(p, 127 - item, blockIdx.x & 7, smem, 1);
#endif
    }
#endif
#ifndef SKIP_SSDY
    for (;;) {
      __syncthreads();
      if (tid == 0) *s_item = (int)atomicAdd(p.counter + 8, 1u);
      __syncthreads();
      const int item = *s_item;
#ifdef PROBE_SSDYX2
      if (item >= 2048) break;
      ssd_y_item(p, item & 1023, smem, item >> 10);
#else
      if (item >= 1024) break;
      ssd_y_item(p, item, smem, 1);
#endif
    }
#endif
  }
  grid_barrier(bar, epoch);
  patch_walk(128, 8, [&](int mt, int nt) { gemm2_tile(p, mt, nt, smem); });
  grid_barrier(bar, epoch);
  patch_walk(128, 8, [&](int mt, int nt) { gemm3_tile(p, mt, nt, smem); });
  grid_barrier(bar, epoch);
#ifdef PROBE_SYNCX
  for (int i = 0; i < 10; ++i) grid_barrier(bar, epoch);
#endif
  {
    const int lane = tid & 63, wave = tid >> 6;
#ifdef PROBE_P37X2
    for (int it = blockIdx.x; it < NTOK / 4; it += gridDim.x) {
      const int row = it * 4 + wave;
      float4* o = (float4*)(p.out + (size_t)row * DM);
      for (int k = 0; k < 4; ++k) { float4 v = o[lane + 64 * k]; v.x += 0.f; o[lane + 64 * k] = v; }
    }
    __syncthreads();
#endif
    for (int it = blockIdx.x; it < NTOK / 4; it += gridDim.x) {
      const int row = it * 4 + wave;
      const float4* sp = (const float4*)(p.ssq2 + (size_t)row * 16);
      const float4 s0 = sp[0], s1 = sp[1], s2 = sp[2], s3 = sp[3];
      const float tot = ((s0.x + s0.y) + (s0.z + s0.w)) + ((s1.x + s1.y) + (s1.z + s1.w)) + ((s2.x + s2.y) + (s2.z + s2.w)) + ((s3.x + s3.y) + (s3.z + s3.w));
      const float r = rsqrtf(tot * (1.f / 1024.f) + EPS);
      float4* o = (float4*)(p.out + (size_t)row * DM);
#pragma unroll
      for (int k = 0; k < 4; ++k) {
        float4 v = o[lane + 64 * k]; const float4 w = ((const float4*)p.final_w)[lane + 64 * k];
        v.x *= r * w.x; v.y *= r * w.y; v.z *= r * w.z; v.w *= r * w.w;
        __builtin_nontemporal_store(f32x4{v.x, v.y, v.z, v.w}, (f32x4*)o + lane + 64 * k);
      }
    }
  }
}

extern "C" void kernel_launch(void* const* d_in, const int* in_sizes, int n_in, void* d_out, int out_size, void* d_ws, size_t ws_size, hipStream_t stream) {
  static int grid_blocks = 0;
  if (!grid_blocks) {
    int dev = 0, cus = 0, per_cu = 0;
    hipGetDevice(&dev);
    hipDeviceGetAttribute(&cus, hipDeviceAttributeMultiprocessorCount, dev);
    hipFuncSetAttribute((const void*)hybrid_fwd, hipFuncAttributeMaxDynamicSharedMemorySize, SMEM_DYN);
    hipOccupancyMaxActiveBlocksPerMultiprocessor(&per_cu, hybrid_fwd, 256, SMEM_DYN);
    if (per_cu < 1) per_cu = 1;
    if (per_cu > 2) per_cu = 2;
    grid_blocks = cus * per_cu;
    if (grid_blocks > 768) grid_blocks = 768;
    grid_blocks &= ~7;
  }
  Params p{};
  const float* const* in = (const float* const*)d_in;
  p.x = in[0]; p.norm_w = in[1]; p.w_in = in[2]; p.conv_w = in[3]; p.conv_b = in[4]; p.dt_bias = in[5]; p.a_log = in[6]; p.d_skip = in[7];
  p.ssm_norm_w = in[8]; p.cmp_pos_k = in[9]; p.cmp_pos_v = in[10]; p.ck_w1 = in[11]; p.ck_b1 = in[12]; p.ck_w2 = in[13];
  p.cv_w1 = in[14]; p.cv_b1 = in[15]; p.cv_w2 = in[16]; p.w_bs = in[17]; p.w_ba = in[18]; p.w_out = in[19]; p.final_w = in[20];
  p.out = (float*)d_out;
  p.xbc = (u16*)d_out;
  unsigned char* w = (unsigned char*)d_ws; size_t off = 0;
  auto take = [&](size_t bytes) { unsigned char* r = w + off; off += (bytes + 255) & ~(size_t)255; return r; };
  p.hbf = (u16*)take((size_t)NTOK * LDH * 2);
  p.wt = (u16*)take((size_t)WT_ROWS * LDH * 2);
  p.wbs_t = (u16*)take((size_t)DM * DM * 2); p.wba_t = (u16*)take((size_t)DM * DM * 2); p.wout_t = (u16*)take((size_t)DM * DM * 2);
  p.w1k_t = (u16*)take((size_t)256 * 2048 * 2); p.w1v_t = (u16*)take((size_t)256 * 2048 * 2);
  p.w2k_t = (u16*)take((size_t)64 * 256 * 2); p.w2v_t = (u16*)take((size_t)64 * 256 * 2);
  p.zs = (u16*)take((size_t)NTOK * DM * 2);
  p.q = (u16*)take((size_t)NTOK * DM * 2);
  const size_t kvb = (size_t)NTOK * 256 * 2;
  p.kcmp = (u16*)take(kvb); p.vcmp = (u16*)take(kvb); p.kslc = (u16*)take(kvb); p.vslcT = (u16*)take(kvb); p.kwin = (u16*)take(kvb); p.vwinT = (u16*)take(kvb);
  p.za = (u16*)take((size_t)NTOK * DM * 2);
  p.states = (float*)take((size_t)2 * 32 * 16 * 8192 * 4);
  p.hid_k = (u16*)take((size_t)4096 * 256 * 2); p.hid_v = (u16*)take((size_t)4096 * 256 * 2);
  p.kc = (u16*)take((size_t)8 * 512 * 64 * 2); p.vcT = (u16*)take((size_t)8 * 64 * 512 * 2);
  p.gates = (float*)take((size_t)NTOK * 48 * 4);
  p.dtv = (float*)take((size_t)NTOK * 16 * 4);
  p.ssq = (float*)take((size_t)NTOK * 16 * 4); p.ssq2 = (float*)take((size_t)NTOK * 16 * 4);
  p.rope = (float*)take((size_t)SEQ * 32 * 2 * 4);
  p.peb = (float*)take(64 * 256 * 4);
  p.cd = (float*)take(2 * 32 * 16 * 4);
  p.counter = (unsigned*)take(16384);
  if (off > ws_size) { fprintf(stderr, "kernel_launch: workspace too small: need %zu, have %zu\n", off, ws_size); return; }
  if (hipMemsetAsync(p.counter, 0, 16384, stream) != hipSuccess) { fprintf(stderr, "kernel_launch: memset of control words failed\n"); return; }
  void* args[] = {&p};
  hipError_t e = hipLaunchCooperativeKernel((void*)hybrid_fwd, dim3(grid_blocks), dim3(256), args, SMEM_DYN, stream);
  if (e != hipSuccess) fprintf(stderr, "cooperative launch failed: %s (grid %d)\n", hipGetErrorString(e), grid_blocks);
}
```

```cpp
#include <hip/hip_runtime.h>
#include <hip/hip_cooperative_groups.h>
#include <cstdio>
namespace cg = cooperative_groups;

typedef unsigned short u16;
typedef unsigned long long u64;
typedef __attribute__((ext_vector_type(8))) short bf16x8;
typedef __attribute__((ext_vector_type(4))) float f32x4;
typedef __attribute__((ext_vector_type(4))) unsigned u32x4;
typedef __attribute__((ext_vector_type(4))) unsigned U4;
typedef __attribute__((ext_vector_type(2))) unsigned U2;
#define DI __device__ __forceinline__

#define NTOK 16384
#define SEQ 8192
#define DM 1024
#define IN_TOTAL 8768
#define NG1 6784
#define WT_ROWS 8832
#define EPS 1e-6f
#define LDH 1152
#define SMEM_BYTES 57344
#define SMEM_DYN (65536 + 1024)
#define RESCALE_SKIP 1

struct Params {
  const float *x, *norm_w, *w_in, *conv_w, *conv_b, *dt_bias, *a_log, *d_skip, *ssm_norm_w, *cmp_pos_k, *cmp_pos_v;
  const float *ck_w1, *ck_b1, *ck_w2, *cv_w1, *cv_b1, *cv_w2, *w_bs, *w_ba, *w_out, *final_w;
  float* out;
  u16 *hbf, *wt, *wbs_t, *wba_t, *wout_t, *w1k_t, *w1v_t, *w2k_t, *w2v_t;
  u16 *zs, *q, *kcmp, *vcmp, *kslc, *vslcT, *kwin, *vwinT, *za, *hid_k, *hid_v, *kc, *vcT, *xbc;
  float *states, *gates, *dtv, *ssq, *ssq2, *rope, *peb, *cd;
  unsigned* counter;
};


DI float bf2f(u16 v) { return __uint_as_float(((unsigned)v) << 16); }
typedef __attribute__((ext_vector_type(2))) __bf16 bf16x2_t;
typedef __attribute__((ext_vector_type(2))) float f32x2;
DI unsigned pack2(float a, float b) { f32x2 v = {a, b}; bf16x2_t r = __builtin_convertvector(v, bf16x2_t); return __builtin_bit_cast(unsigned, r); }
DI float lo_f(unsigned v) { return __uint_as_float(v << 16); }
DI float hi_f(unsigned v) { return __uint_as_float(v & 0xffff0000u); }
DI float silu_f(float x) { return x * __builtin_amdgcn_rcpf(1.f + __expf(-x)); }
DI float sigmoid_f(float x) { return __builtin_amdgcn_rcpf(1.f + __expf(-x)); }
DI float softplus_f(float x) { return fmaxf(x, 0.f) + log1pf(__expf(-fabsf(x))); }
DI float gelu_tanh(float x) { float u = 0.7978845608028654f * (x + 0.044715f * x * x * x); return 0.5f * x * (1.f + tanhf(u)); }
DI u16 f2bf(float x) { return (u16)(pack2(x, 0.f) & 0xffffu); }
DI float exp2_f(float x) { return __builtin_amdgcn_exp2f(x); }
DI f32x4 mfma16(bf16x8 a, bf16x8 b, f32x4 c) { return __builtin_amdgcn_mfma_f32_16x16x32_bf16(a, b, c, 0, 0, 0); }
DI bf16x8 as_bf16x8(U4 v) { return __builtin_bit_cast(bf16x8, v); }
DI bf16x8 as_bf16x8(unsigned a, unsigned b, unsigned c, unsigned d) { u32x4 t = {a, b, c, d}; return __builtin_bit_cast(bf16x8, t); }
DI float max3_f(float a, float b, float c) { float r; asm("v_max3_f32 %0, %1, %2, %3" : "=v"(r) : "v"(a), "v"(b), "v"(c)); return r; }
DI float quad_max(float v) {
  unsigned u = __float_as_uint(v);
  auto a = __builtin_amdgcn_permlane16_swap(u, u, false, false);
  v = max3_f(__uint_as_float(a[0]), __uint_as_float(a[1]), __uint_as_float(a[1]));
  u = __float_as_uint(v);
  auto b = __builtin_amdgcn_permlane32_swap(u, u, false, false);
  return max3_f(__uint_as_float(b[0]), __uint_as_float(b[1]), __uint_as_float(b[1]));
}
DI float quad_sum(float v) {
  unsigned u = __float_as_uint(v);
  auto a = __builtin_amdgcn_permlane16_swap(u, u, false, false);
  v = __uint_as_float(a[0]) + __uint_as_float(a[1]);
  u = __float_as_uint(v);
  auto b = __builtin_amdgcn_permlane32_swap(u, u, false, false);
  return __uint_as_float(b[0]) + __uint_as_float(b[1]);
}
typedef __attribute__((ext_vector_type(4))) short s16x4;
DI bf16x8 tr_frag(const u16* a0, const u16* a1) {
  const s16x4 x = __builtin_amdgcn_ds_read_tr16_b64_v4i16((__attribute__((address_space(3))) s16x4*)a0);
  const s16x4 y = __builtin_amdgcn_ds_read_tr16_b64_v4i16((__attribute__((address_space(3))) s16x4*)a1);
  return __builtin_shufflevector(x, y, 0, 1, 2, 3, 4, 5, 6, 7);
}
DI int otid() { int t = threadIdx.x; asm volatile("" : "+v"(t)); return t; }
DI float wave_sum(float v) {
#pragma unroll
  for (int o = 32; o > 0; o >>= 1) v += __shfl_xor(v, o, 64);
  return v;
}
DI int srccol(int n) {
  if (n < 3072) return n;
  if (n < 5632) return n + 16;
  if (n < 6656) return n + 64;
  if (n < 6704) return n - 6656 + 5648;
  if (n < 6720) return n - 6704 + 3072;
  if (n < 6784) return -1;
  return n - 6784 + 6720;
}

DI void wt_tile(const float* src, int ld_src, int k0, int n0, u16* dst, int ld_dst, int mode, const float* kscale, float* tile) {
  const int tid = otid(), n4 = (tid & 15) * 4, kl0 = tid >> 4;
  const int n = n0 + n4;
  const int sc = (mode == 1) ? srccol(n) : n;
#pragma unroll
  for (int i = 0; i < 4; ++i) {
    const int kl = kl0 + 16 * i;
    f32x4 v = {0.f, 0.f, 0.f, 0.f};
    if (sc >= 0) v = __builtin_nontemporal_load((const f32x4*)(src + (size_t)(k0 + kl) * ld_src + sc));
    if (kscale) v *= kscale[k0 + kl];
    tile[kl * 65 + n4] = v[0]; tile[kl * 65 + n4 + 1] = v[1]; tile[kl * 65 + n4 + 2] = v[2]; tile[kl * 65 + n4 + 3] = v[3];
  }
  __syncthreads();
  const int nr = tid >> 2, kc = (tid & 3) * 16;
  unsigned w[8];
#pragma unroll
  for (int e = 0; e < 8; ++e) w[e] = pack2(tile[(kc + 2 * e) * 65 + nr], tile[(kc + 2 * e + 1) * 65 + nr]);
  U4* d = (U4*)(dst + (size_t)(n0 + nr) * ld_dst + k0 + kc);
  d[0] = U4{w[0], w[1], w[2], w[3]};
  d[1] = U4{w[4], w[5], w[6], w[7]};
  __syncthreads();
}

DI void phase0(const Params& p, unsigned char* smem) {
  const int tid = otid(), lane = tid & 63, wave = tid >> 6;
  float* tile = (float*)smem;
  const int NA = 4096, NB = 138 * 16, NC = 768, ND = 256, NE = 8, NF = 1024, NGI = 64;
  const int total = NA + NB + NC + ND + NE + NF + NGI;
  for (int it = blockIdx.x; it < total; it += gridDim.x) {
    int i = it;
    if (i < NA) {
      const int row = i * 4 + wave;
      const float4* xr = (const float4*)(p.x + (size_t)row * DM);
      float4 v[4]; float ss = 0.f;
#pragma unroll
      for (int k = 0; k < 4; ++k) { const f32x4 t4 = __builtin_nontemporal_load((const f32x4*)xr + lane + 64 * k); v[k] = make_float4(t4[0], t4[1], t4[2], t4[3]); ss += v[k].x * v[k].x + v[k].y * v[k].y + v[k].z * v[k].z + v[k].w * v[k].w; }
      ss = wave_sum(ss);
      const float r = rsqrtf(ss * (1.f / DM) + EPS);
#pragma unroll
      for (int k = 0; k < 4; ++k) {
        const float4 w4 = ((const float4*)p.norm_w)[lane + 64 * k];
        U2 o; o.x = pack2(v[k].x * r * w4.x, v[k].y * r * w4.y); o.y = pack2(v[k].z * r * w4.z, v[k].w * r * w4.w);
        *(U2*)(p.hbf + (size_t)row * LDH + (lane + 64 * k) * 4) = o;
      }
      continue;
    }
    i -= NA;
    if (i < NB) { wt_tile(p.w_in, IN_TOTAL, (i & 15) * 64, (i >> 4) * 64, p.wt, LDH, 1, nullptr, tile); continue; }
    i -= NB;
    if (i < NC) {
      const int which = i >> 8, t = i & 255;
      const float* src = which == 0 ? p.w_bs : (which == 1 ? p.w_ba : p.w_out);
      u16* dst = which == 0 ? p.wbs_t : (which == 1 ? p.wba_t : p.wout_t);
      wt_tile(src, DM, (t & 15) * 64, (t >> 4) * 64, dst, DM, 0, which == 0 ? p.ssm_norm_w : nullptr, tile);
      continue;
    }
    i -= NC;
    if (i < ND) {
      const int which = i >> 7, t = i & 127;
      wt_tile(which ? p.cv_w1 : p.ck_w1, 256, (t & 31) * 64, (t >> 5) * 64, which ? p.w1v_t : p.w1k_t, 2048, 0, nullptr, tile);
      continue;
    }
    i -= ND;
    if (i < NE) {
      const int which = i >> 2, t = i & 3;
      wt_tile(which ? p.cv_w2 : p.ck_w2, 64, t * 64, 0, which ? p.w2v_t : p.w2k_t, 256, 0, nullptr, tile);
      continue;
    }
    i -= NE;
    if (i < NF) {
      const int e = i * 256 + tid; const int t = e >> 5, d = e & 31;
      const float inv = 1.0f / powf(10000.0f, (float)d * (2.0f / 64.0f));
      const float ang = (float)t * inv;
      float s, c; sincosf(ang, &s, &c);
      ((float2*)p.rope)[e] = make_float2(c, s);
      continue;
    }
    i -= NF;
    {
      const int which = i >> 5, chunk = i & 31;
      const float* w1 = which ? p.cv_w1 : p.ck_w1; const float* pe = which ? p.cmp_pos_v : p.cmp_pos_k;
      float acc = 0.f;
#pragma unroll 8
      for (int k = chunk * 64; k < chunk * 64 + 64; ++k) acc += pe[k] * w1[k * 256 + tid];
      p.peb[i * 256 + tid] = acc;
    }
  }
}

DI void glds16(const void* g, void* l) {
  __builtin_amdgcn_global_load_lds((const __attribute__((address_space(1))) unsigned*)g, (__attribute__((address_space(3))) unsigned*)l, 16, 0, 0);
}
template <int N> DI void wait_vm() { asm volatile("s_waitcnt vmcnt(%0)" ::"n"(N) : "memory"); }
DI void raw_barrier() { asm volatile("s_waitcnt lgkmcnt(0)" ::: "memory"); __builtin_amdgcn_s_barrier(); }

template <int MT, int NT>
DI void gemm_core(const u16* A, int lda, const u16* Bt, int ldb, int K, f32x4 (&acc)[MT][NT], u16* sm) {
  constexpr int BM = MT * 32, BN = NT * 32;
  constexpr int AI = BM / 32, BI = BN / 32;
  constexpr int STAGE = (BM + BN) * 128;
  static_assert(2 * STAGE <= 65536, "ring does not fit");
  unsigned char* base = (unsigned char*)sm;
  const int tid = otid(), lane = tid & 63, wave = tid >> 6, wm = wave >> 1, wn = wave & 1;
  const int l15 = lane & 15, q = lane >> 4;
  const int lrow = lane >> 3;
  const int lc = (lane & 7) ^ (((wave & 1) * 4 + (lane >> 4)) & 7);
  const u16* Ag = A + (size_t)(wave * 8 + lrow) * lda + lc * 8;
  const u16* Bg = Bt + (size_t)(wave * 8 + lrow) * ldb + lc * 8;
  const int wofs = wave * 8 * 128;
  const int nkt = K >> 6;
  raw_barrier();
#pragma unroll
  for (int i = 0; i < AI; ++i) glds16(Ag + (size_t)(i * 32) * lda, base + i * 4096 + wofs);
#pragma unroll
  for (int i = 0; i < BI; ++i) glds16(Bg + (size_t)(i * 32) * ldb, base + BM * 128 + i * 4096 + wofs);
  const int sw = (l15 >> 1) & 7;
  const int arow = (wm * MT * 16 + l15) * 128, brow = BM * 128 + (wn * NT * 16 + l15) * 128;
  int cb = 0;
  for (int kt = 0; kt < nkt; ++kt) {
    wait_vm<0>();
    raw_barrier();
    if (kt + 1 < nkt) {
      unsigned char* sb = base + (cb ^ 1) * STAGE;
      const int k0 = (kt + 1) * 64;
#pragma unroll
      for (int i = 0; i < AI; ++i) glds16(Ag + (size_t)(i * 32) * lda + k0, sb + i * 4096 + wofs);
#pragma unroll
      for (int i = 0; i < BI; ++i) glds16(Bg + (size_t)(i * 32) * ldb + k0, sb + BM * 128 + i * 4096 + wofs);
    }
    const unsigned char* cs = base + cb * STAGE;
#pragma unroll
    for (int ks = 0; ks < 2; ++ks) {
      const int pc = ((ks * 4 + q) ^ sw) * 16;
      bf16x8 af[MT], bfr[NT];
#pragma unroll
      for (int mt = 0; mt < MT; ++mt) af[mt] = *(const bf16x8*)(cs + arow + mt * 2048 + pc);
#pragma unroll
      for (int nt = 0; nt < NT; ++nt) bfr[nt] = *(const bf16x8*)(cs + brow + nt * 2048 + pc);
#pragma unroll
      for (int mt = 0; mt < MT; ++mt)
#pragma unroll
        for (int nt = 0; nt < NT; ++nt) acc[mt][nt] = mfma16(af[mt], bfr[nt], acc[mt][nt]);
    }
    cb ^= 1;
  }
}

template <int MT, int NT>
DI void zero_acc(f32x4 (&acc)[MT][NT]) {
#pragma unroll
  for (int a = 0; a < MT; ++a)
#pragma unroll
    for (int b = 0; b < NT; ++b) acc[a][b] = f32x4{0.f, 0.f, 0.f, 0.f};
}

template <int PM = 8, int PN = 8, class F>
DI void patch_walk(int MT_, int NT_, F f) {
  static_assert(PM * PN == 64, "a patch is 64 tiles");
  const int xcd = blockIdx.x & 7, local = blockIdx.x >> 3, L = gridDim.x >> 3;
  const int npc = (NT_ + PN - 1) / PN, npatch = ((MT_ + PM - 1) / PM) * npc;
  for (int s = local;; s += L) {
    const int P = (s >> 6) * 8 + xcd;
    if (P >= npatch) break;
    const int w = s & 63;
    const int mt = (P / npc) * PM + (w / PN), nt = (P % npc) * PN + (w % PN);
    if (mt < MT_ && nt < NT_) f(mt, nt);
  }
}

DI void gemm1_tile(const Params& p, int mt_i, int nt_i, unsigned char* smem) {
  const int m0 = mt_i * 128, n0 = nt_i * 128;
  f32x4 acc[4][4]; zero_acc(acc);
  gemm_core<4, 4>(p.hbf + (size_t)m0 * LDH, LDH, p.wt + (size_t)n0 * LDH, LDH, DM, acc, (u16*)smem);
  const int tid = otid(), lane = tid & 63, wave = tid >> 6, wm = wave >> 1, wn = wave & 1, l15 = lane & 15, q = lane >> 4;
  const int col0 = n0 + wn * 64, rbase = m0 + wm * 64;
#ifdef PROBE_EPIX2
#pragma unroll 1
  for (int rep = 0; rep < 2; ++rep)
#endif
  if (col0 < 1024) {
#pragma unroll
    for (int mt = 0; mt < 4; ++mt)
#pragma unroll
      for (int nt = 0; nt < 4; ++nt)
#pragma unroll
        for (int j = 0; j < 4; ++j) __builtin_nontemporal_store(f2bf(silu_f(acc[mt][nt][j])), &p.zs[(size_t)(rbase + mt * 16 + q * 4 + j) * 1024 + col0 + nt * 16 + l15]);
  } else if (col0 < 3072) {
    u16* halo = (u16*)p.states;
#pragma unroll
    for (int mt = 0; mt < 4; ++mt)
#pragma unroll
      for (int nt = 0; nt < 4; ++nt)
#pragma unroll
        for (int j = 0; j < 4; ++j) {
          const u16 v = f2bf(acc[mt][nt][j]);
          __builtin_nontemporal_store(v, &p.xbc[(size_t)(rbase + mt * 16 + q * 4 + j) * 2048 + (col0 - 1024) + nt * 16 + l15]);
          if (mt == 3 && j >= 1 && q == 3) halo[(size_t)((rbase >> 6) * 3 + (j - 1)) * 2048 + (col0 - 1024) + nt * 16 + l15] = v;
        }
  } else if (col0 < 4096) {
    const int hc = col0 - 3072;
#pragma unroll
    for (int mt = 0; mt < 4; ++mt)
#pragma unroll
      for (int j = 0; j < 4; ++j) {
        const int row = rbase + mt * 16 + q * 4 + j; const int t = row & (SEQ - 1);
#pragma unroll
        for (int nt = 0; nt < 2; ++nt) {
          const int d = nt * 16 + l15;
          const float2 cs = ((const float2*)p.rope)[t * 32 + d];
          const float u1 = acc[mt][nt][j], u2 = acc[mt][nt + 2][j];
          p.q[(size_t)row * 1024 + hc + d] = f2bf((u1 * cs.x - u2 * cs.y) * 0.18033688011112042f);
          p.q[(size_t)row * 1024 + hc + d + 32] = f2bf((u2 * cs.x + u1 * cs.y) * 0.18033688011112042f);
        }
      }
  } else if (col0 < 5632) {
    const int kc0 = col0 - 4096; const int s6 = kc0 >> 8; const int g = (kc0 & 255) >> 6;
    const int b = rbase >> 13;
    if (s6 == 3 || s6 == 5) {
      u16* dst = (s6 == 3 ? p.vslcT : p.vwinT) + (size_t)(b * 4 + g) * 64 * SEQ;
#pragma unroll
      for (int mt = 0; mt < 4; ++mt)
#pragma unroll
        for (int nt = 0; nt < 4; ++nt) {
          const int t0 = (rbase + mt * 16 + q * 4) & (SEQ - 1); const int d = nt * 16 + l15;
          U2 o; o.x = pack2(acc[mt][nt][0], acc[mt][nt][1]); o.y = pack2(acc[mt][nt][2], acc[mt][nt][3]);
          *(U2*)(dst + (size_t)d * SEQ + t0) = o;
        }
    } else if (s6 == 1) {
      u16* dst = p.vcmp + (size_t)(b * 4 + g) * SEQ * 64;
#pragma unroll
      for (int mt = 0; mt < 4; ++mt)
#pragma unroll
        for (int nt = 0; nt < 4; ++nt)
#pragma unroll
          for (int j = 0; j < 4; ++j) dst[(size_t)((rbase + mt * 16 + q * 4 + j) & (SEQ - 1)) * 64 + nt * 16 + l15] = f2bf(acc[mt][nt][j]);
    } else {
      u16* dst = (s6 == 0 ? p.kcmp : (s6 == 2 ? p.kslc : p.kwin)) + (size_t)(b * 4 + g) * SEQ * 64;
#pragma unroll
      for (int mt = 0; mt < 4; ++mt)
#pragma unroll
        for (int j = 0; j < 4; ++j) {
          const int t = (rbase + mt * 16 + q * 4 + j) & (SEQ - 1);
#pragma unroll
          for (int nt = 0; nt < 2; ++nt) {
            const int d = nt * 16 + l15;
            const float2 cs = ((const float2*)p.rope)[t * 32 + d];
            const float u1 = acc[mt][nt][j], u2 = acc[mt][nt + 2][j];
            dst[(size_t)t * 64 + d] = f2bf(u1 * cs.x - u2 * cs.y);
            dst[(size_t)t * 64 + d + 32] = f2bf(u2 * cs.x + u1 * cs.y);
          }
        }
    }
  } else if (col0 < 6656) {
#pragma unroll
    for (int mt = 0; mt < 4; ++mt)
#pragma unroll
      for (int nt = 0; nt < 4; ++nt)
#pragma unroll
        for (int j = 0; j < 4; ++j) __builtin_nontemporal_store(f2bf(silu_f(acc[mt][nt][j])), &p.za[(size_t)(rbase + mt * 16 + q * 4 + j) * 1024 + (col0 - 5632) + nt * 16 + l15]);
  } else if (col0 < 6720) {
    const float dtb = p.dt_bias[l15];
#pragma unroll
    for (int mt = 0; mt < 4; ++mt)
#pragma unroll
      for (int j = 0; j < 4; ++j) {
        const int row = rbase + mt * 16 + q * 4 + j;
#pragma unroll
        for (int nt = 0; nt < 3; ++nt) p.gates[(size_t)row * 48 + nt * 16 + l15] = sigmoid_f(acc[mt][nt][j]);
        p.dtv[(size_t)row * 16 + l15] = softplus_f(acc[mt][3][j] + dtb);
      }
  }
}

DI void gemm1_mini_tile(const Params& p, int mt_i, unsigned char* smem) {
  const int m0 = mt_i * 64;
  f32x4 acc[2][2]; zero_acc(acc);
  gemm_core<2, 2>(p.hbf + (size_t)m0 * LDH, LDH, p.wt + (size_t)6656 * LDH, LDH, DM, acc, (u16*)smem);
  const int tid = otid(), lane = tid & 63, wave = tid >> 6, wm = wave >> 1, wn = wave & 1, l15 = lane & 15, q = lane >> 4;
  const float dtb = p.dt_bias[l15];
#pragma unroll
  for (int mt = 0; mt < 2; ++mt)
#pragma unroll
    for (int j = 0; j < 4; ++j) {
      const int row = m0 + wm * 32 + mt * 16 + q * 4 + j;
      if (wn == 0) {
        p.gates[(size_t)row * 48 + l15] = sigmoid_f(acc[mt][0][j]);
        p.gates[(size_t)row * 48 + 16 + l15] = sigmoid_f(acc[mt][1][j]);
      } else {
        p.gates[(size_t)row * 48 + 32 + l15] = sigmoid_f(acc[mt][0][j]);
        p.dtv[(size_t)row * 16 + l15] = softplus_f(acc[mt][1][j] + dtb);
      }
    }
}

DI void unpack8(const U4& v, float (&f)[8]) {
  f[0] = lo_f(v.x); f[1] = hi_f(v.x); f[2] = lo_f(v.y); f[3] = hi_f(v.y); f[4] = lo_f(v.z); f[5] = hi_f(v.z); f[6] = lo_f(v.w); f[7] = hi_f(v.w);
}
template <int NCH, int RPS>
DI void conv_fetch(const Params& p, U4 (&u)[RPS + 3], int grow0, int t0, int ch0) {
  constexpr int NCG = NCH / 8;
  const int tid = otid(); const int cgi = tid % NCG, seg = tid / NCG;
  int ch = ch0 + cgi * 8;
  asm volatile("" : "+v"(ch));
  const u16* src = p.xbc + (size_t)grow0 * 2048 + ch;
  const int r0 = seg * RPS;
#pragma unroll
  for (int k = 0; k < RPS; ++k) u[k + 3] = *(const U4*)(src + (r0 + k) * 2048);
}
template <int NCH, int RPS>
DI void conv_apply(const Params& p, const U4 (&u)[RPS + 3], u16* dst, int dstride, int ch0, const float* rscale) {
  constexpr int NCG = NCH / 8;
  const int tid = otid(); const int cgi = tid % NCG, seg = tid / NCG;
  const int r0 = seg * RPS;
#pragma unroll
  for (int k = 0; k < RPS; ++k) {
    U4 v = u[k + 3];
    if (rscale) {
      float f0[8]; unpack8(v, f0);
      const float sc = rscale[r0 + k];
      v = U4{pack2(f0[0] * sc, f0[1] * sc), pack2(f0[2] * sc, f0[3] * sc), pack2(f0[4] * sc, f0[5] * sc), pack2(f0[6] * sc, f0[7] * sc)};
    }
    *(U4*)(dst + (r0 + k) * dstride + cgi * 8) = v;
  }
}
template <int NCH, int RPS>
DI void conv_load(const Params& p, u16* dst, int dstride, int grow0, int t0, int ch0, const float* rscale) {
  U4 u[RPS + 3];
  conv_fetch<NCH, RPS>(p, u, grow0, t0, ch0);
  conv_apply<NCH, RPS>(p, u, dst, dstride, ch0, rscale);
}

DI void preconv_item(const Params& p, int item) {
  const int tid = otid();
  const int slab = item >> 1, chalf = item & 1;
  const int cgi = tid & 127, rh = tid >> 7;
  const int ch = chalf * 1024 + cgi * 8;
  const int r0 = slab * 64 + rh * 32;
  float w0[8], w1[8], w2[8], w3[8], bs[8];
#pragma unroll
  for (int h = 0; h < 2; ++h) {
    const float4 a0 = *(const float4*)(p.conv_w + 0 * 2048 + ch + h * 4), a1 = *(const float4*)(p.conv_w + 1 * 2048 + ch + h * 4);
    const float4 a2 = *(const float4*)(p.conv_w + 2 * 2048 + ch + h * 4), a3 = *(const float4*)(p.conv_w + 3 * 2048 + ch + h * 4);
    const float4 bb = *(const float4*)(p.conv_b + ch + h * 4);
    w0[h * 4 + 0] = a0.x; w0[h * 4 + 1] = a0.y; w0[h * 4 + 2] = a0.z; w0[h * 4 + 3] = a0.w;
    w1[h * 4 + 0] = a1.x; w1[h * 4 + 1] = a1.y; w1[h * 4 + 2] = a1.z; w1[h * 4 + 3] = a1.w;
    w2[h * 4 + 0] = a2.x; w2[h * 4 + 1] = a2.y; w2[h * 4 + 2] = a2.z; w2[h * 4 + 3] = a2.w;
    w3[h * 4 + 0] = a3.x; w3[h * 4 + 1] = a3.y; w3[h * 4 + 2] = a3.z; w3[h * 4 + 3] = a3.w;
    bs[h * 4 + 0] = bb.x; bs[h * 4 + 1] = bb.y; bs[h * 4 + 2] = bb.z; bs[h * 4 + 3] = bb.w;
  }
  u16* xb = p.xbc + (size_t)r0 * 2048 + ch;
  const U4 z4 = U4{0u, 0u, 0u, 0u};
  U4 um3, um2, um1;
  if (rh == 1) {
    um3 = *(const U4*)(xb - 3 * 2048); um2 = *(const U4*)(xb - 2 * 2048); um1 = *(const U4*)(xb - 1 * 2048);
  } else if ((r0 & (SEQ - 1)) == 0) {
    um3 = z4; um2 = z4; um1 = z4;
  } else {
    const u16* hp = (const u16*)p.states + (size_t)((slab - 1) * 3) * 2048 + ch;
    um3 = *(const U4*)hp; um2 = *(const U4*)(hp + 2048); um1 = *(const U4*)(hp + 4096);
  }
  __syncthreads();
#pragma unroll 1
  for (int rb8 = 0; rb8 < 32; rb8 += 8) {
    U4 u[8];
#pragma unroll
    for (int k = 0; k < 8; ++k) u[k] = *(const U4*)(xb + (rb8 + k) * 2048);
#pragma unroll
    for (int k = 0; k < 8; ++k) {
      float f3[8], f2[8], f1[8], f0[8], o[8];
      unpack8(um3, f3); unpack8(um2, f2); unpack8(um1, f1); unpack8(u[k], f0);
#pragma unroll
      for (int e = 0; e < 8; ++e) o[e] = silu_f(bs[e] + w0[e] * f3[e] + w1[e] * f2[e] + w2[e] * f1[e] + w3[e] * f0[e]);
      *(U4*)(xb + (rb8 + k) * 2048) = U4{pack2(o[0], o[1]), pack2(o[2], o[3]), pack2(o[4], o[5]), pack2(o[6], o[7])};
      um3 = um2; um2 = um1; um1 = u[k];
    }
  }
}

DI float block_scan256(float v, float* tmp  ) {
  const int lane = threadIdx.x & 63, wave = threadIdx.x >> 6;
#pragma unroll
  for (int o = 1; o < 64; o <<= 1) { const float t = __shfl_up(v, o, 64); if (lane >= o) v += t; }
  if (lane == 63) tmp[wave] = v;
  __syncthreads();
  float add = 0.f;
  if (wave > 0) add += tmp[0];
  if (wave > 1) add += tmp[1];
  if (wave > 2) add += tmp[2];
  return v + add;
}
DI void scan256(float* a) {
  const int tid = otid();
  for (int off = 1; off < 256; off <<= 1) {
    const float t = (tid >= off) ? a[tid - off] : 0.f;
    __syncthreads();
    a[tid] += t;
    __syncthreads();
  }
}

DI void ssd_states_item(const Params& p, int item, unsigned char* smem) {
  const int tid = otid(), lane = tid & 63, wave = tid >> 6, l15 = lane & 15, q = lane >> 4;
  const int b = item >> 9, c = (item >> 4) & 31, h = item & 15, g = h >> 2;
  float* acs = (float*)smem; float* wsc = acs + 256;
  u16* Xs = (u16*)(smem + 2048); u16* Bs = Xs + 128 * 72;
  const int rb = b * SEQ + c * 256;
  const float A_h = -expf(p.a_log[h]);
  const float dtl = p.dtv[(size_t)(rb + tid) * 16 + h];
  __syncthreads();
  acs[tid] = block_scan256(dtl * A_h, (float*)(smem + 65536 + 16));
  __syncthreads();
  const float tot = acs[255];
  wsc[tid] = __expf(tot - acs[tid]) * dtl;
  if (tid == 255) p.cd[(b * 32 + c) * 16 + h] = __expf(tot);
  f32x4 acc[4][2]; zero_acc(acc);
  for (int half = 0; half < 2; ++half) {
    __syncthreads();
    {
      U4 ux[7], ub[11];
      conv_fetch<64, 4>(p, ux, rb + half * 128, c * 256 + half * 128, h * 64);
      conv_fetch<128, 8>(p, ub, rb + half * 128, c * 256 + half * 128, 1024 + g * 128);
      conv_apply<64, 4>(p, ux, Xs, 72, h * 64, wsc + half * 128);
      conv_apply<128, 8>(p, ub, Bs, 136, 1024 + g * 128, nullptr);
    }
    __syncthreads();
#pragma unroll
    for (int ks = 0; ks < 4; ++ks) {
      bf16x8 af[4], bfr[2];
#pragma unroll
      for (int pt = 0; pt < 4; ++pt) {
        const u16* s = Xs + (ks * 32 + q * 8 + (l15 >> 2)) * 72 + pt * 16 + (l15 & 3) * 4;
        af[pt] = tr_frag(s, s + 4 * 72);
      }
#pragma unroll
      for (int nt = 0; nt < 2; ++nt) {
        const u16* s = Bs + (ks * 32 + q * 8 + (l15 >> 2)) * 136 + (wave * 2 + nt) * 16 + (l15 & 3) * 4;
        bfr[nt] = tr_frag(s, s + 4 * 136);
      }
#pragma unroll
      for (int pt = 0; pt < 4; ++pt)
#pragma unroll
        for (int nt = 0; nt < 2; ++nt) acc[pt][nt] = mfma16(af[pt], bfr[nt], acc[pt][nt]);
    }
  }
  float* st = p.states + (size_t)item * 8192;
#pragma unroll
  for (int pt = 0; pt < 4; ++pt)
#pragma unroll
    for (int nt = 0; nt < 2; ++nt)
#pragma unroll
      for (int j = 0; j < 4; ++j) st[(pt * 16 + q * 4 + j) * 128 + (wave * 2 + nt) * 16 + l15] = acc[pt][nt][j];
}

DI void cmp_a_tile(const Params& p, int tile, unsigned char* smem) {
  const int which = tile >> 7, r = tile & 127; const int bg = r >> 4, mt_i = (r >> 1) & 7, nt_i = r & 1;
  const u16* A = (which ? p.vcmp : p.kcmp) + (size_t)bg * SEQ * 64 + (size_t)(mt_i * 64) * 1024;
  const u16* Bt = (which ? p.w1v_t : p.w1k_t) + (size_t)(nt_i * 128) * 2048;
  f32x4 acc[2][4]; zero_acc(acc);
  gemm_core<2, 4>(A, 1024, Bt, 2048, 2048, acc, (u16*)smem);
  const int tid = otid(), lane = tid & 63, wave = tid >> 6, wm = wave >> 1, wn = wave & 1, l15 = lane & 15, q = lane >> 4;
  u16* hid = which ? p.hid_v : p.hid_k;
#pragma unroll
  for (int nt = 0; nt < 4; ++nt) {
    const int col = nt_i * 128 + wn * 64 + nt * 16 + l15;
    float bias = (which ? p.cv_b1 : p.ck_b1)[col];
    for (int c = 0; c < 32; ++c) bias += p.peb[(which * 32 + c) * 256 + col];
#pragma unroll
    for (int mt = 0; mt < 2; ++mt)
#pragma unroll
      for (int j = 0; j < 4; ++j) {
        const int row = bg * 512 + mt_i * 64 + wm * 32 + mt * 16 + q * 4 + j;
        hid[(size_t)row * 256 + col] = f2bf(gelu_tanh(acc[mt][nt][j] + bias));
      }
  }
}

DI void scan_item(const Params& p, int item) {
  const int e4 = item * 256 + threadIdx.x;
  const int b = e4 >> 15, h = (e4 >> 11) & 15, r = e4 & 2047;
  float4* st = (float4*)p.states;
  float4 carry = make_float4(0.f, 0.f, 0.f, 0.f);
#pragma unroll 1
  for (int c0 = 0; c0 < 32; c0 += 16) {
    float4 sv[16]; float dv[16];
#pragma unroll
    for (int k = 0; k < 16; ++k) { sv[k] = st[(size_t)((b * 32 + c0 + k) * 16 + h) * 2048 + r]; dv[k] = p.cd[(b * 32 + c0 + k) * 16 + h]; }
#pragma unroll
    for (int k = 0; k < 16; ++k) {
      st[(size_t)((b * 32 + c0 + k) * 16 + h) * 2048 + r] = carry;
      carry.x = dv[k] * carry.x + sv[k].x; carry.y = dv[k] * carry.y + sv[k].y; carry.z = dv[k] * carry.z + sv[k].z; carry.w = dv[k] * carry.w + sv[k].w;
    }
  }
}

DI void cmp_b_tile(const Params& p, int tile, unsigned char* smem) {
  const int which = tile >> 5, mt_i = tile & 31;
  f32x4 acc[4][2]; zero_acc(acc);
  gemm_core<4, 2>((which ? p.hid_v : p.hid_k) + (size_t)(mt_i * 128) * 256, 256, which ? p.w2v_t : p.w2k_t, 256, 256, acc, (u16*)smem);
  const int tid = otid(), lane = tid & 63, wave = tid >> 6, wm = wave >> 1, wn = wave & 1, l15 = lane & 15, q = lane >> 4;
#pragma unroll
  for (int mt = 0; mt < 4; ++mt)
#pragma unroll
    for (int nt = 0; nt < 2; ++nt) {
      const int row0 = mt_i * 128 + wm * 64 + mt * 16 + q * 4; const int col = wn * 32 + nt * 16 + l15;
      const int bg = row0 >> 9, i0 = row0 & 511;
      if (which == 0) {
#pragma unroll
        for (int j = 0; j < 4; ++j) p.kc[(size_t)(row0 + j) * 64 + col] = (i0 + j == 511) ? (u16)0 : f2bf(acc[mt][nt][j]);
      } else {
        U2 o; o.x = pack2(acc[mt][nt][0], acc[mt][nt][1]); o.y = pack2(acc[mt][nt][2], (i0 + 3 == 511) ? 0.f : acc[mt][nt][3]);
        *(U2*)(p.vcT + (size_t)(bg * 64 + col) * 512 + i0) = o;
      }
    }
}

DI void ssd_y_item(const Params& p, int item, unsigned char* smem, int rep) {
  const int tid = otid(), lane = tid & 63, wave = tid >> 6, l15 = lane & 15, q = lane >> 4;
  const int b = item >> 9, c = (item >> 4) & 31, h = item & 15, g = h >> 2;
  float* acs = (float*)smem; float* dts = acs + 256;
  u16* R1 = (u16*)(smem + 2048);
  u16* Ps = (u16*)(smem + 2048 + 34816);
  u16* Bts = R1; u16* Xts = R1 + 64 * 136;
  const int rb = b * SEQ + c * 256;
  const float A_h = -expf(p.a_log[h]);
  const float Dh = p.d_skip[h];
  const float dtl = p.dtv[(size_t)(rb + tid) * 16 + h];
  __syncthreads();
  acs[tid] = block_scan256(dtl * A_h, (float*)(smem + 65536 + 16)); dts[tid] = dtl;
  __syncthreads();
  {
    const float4* st = (const float4*)(p.states + (size_t)item * 8192);
#pragma unroll
    for (int i = 0; i < 8; ++i) {
      const int idx = tid + i * 256; const float4 v = st[idx];
      U2 o; o.x = pack2(v.x, v.y); o.y = pack2(v.z, v.w);
      *(U2*)(Ps + (idx >> 5) * 136 + (idx & 31) * 4) = o;
    }
  }
  for (int lh = 0; lh < 2; ++lh) {
    __syncthreads();
    conv_load<128, 8>(p, R1, 136, rb + lh * 128, c * 256 + lh * 128, 1536 + g * 128, nullptr);
    __syncthreads();
    bf16x8 Cf[2][4]; int lrow[2]; float acl[2];
#pragma unroll
    for (int nt = 0; nt < 2; ++nt) {
      lrow[nt] = lh * 128 + wave * 32 + nt * 16 + l15; acl[nt] = acs[lrow[nt]];
#pragma unroll
      for (int ks = 0; ks < 4; ++ks) Cf[nt][ks] = *(const bf16x8*)(R1 + (wave * 32 + nt * 16 + l15) * 136 + ks * 32 + q * 8);
    }
    f32x4 O[4][2]; zero_acc(O);
#pragma unroll
    for (int dt = 0; dt < 4; ++dt)
#pragma unroll
      for (int ks = 0; ks < 4; ++ks) {
        const bf16x8 a = *(const bf16x8*)(Ps + (dt * 16 + l15) * 136 + ks * 32 + q * 8);
#pragma unroll
        for (int nt = 0; nt < 2; ++nt) O[dt][nt] = mfma16(a, Cf[nt][ks], O[dt][nt]);
      }
#pragma unroll
    for (int nt = 0; nt < 2; ++nt) {
      const float e = __expf(acl[nt]);
#pragma unroll
      for (int dt = 0; dt < 4; ++dt) O[dt][nt] *= e;
    }
    const int nsb = lh * 2 + 2;
    for (int sb = 0; sb < nsb; ++sb) {
      __syncthreads();
      {
        U4 ub[7], ux[5];
        conv_fetch<128, 4>(p, ub, rb + sb * 64, c * 256 + sb * 64, 1024 + g * 128);
        conv_fetch<64, 2>(p, ux, rb + sb * 64, c * 256 + sb * 64, h * 64);
        conv_apply<128, 4>(p, ub, Bts, 136, 1024 + g * 128, nullptr);
        conv_apply<64, 2>(p, ux, Xts, 72, h * 64, nullptr);
      }
      __syncthreads();
      if (sb * 64 <= lh * 128 + wave * 32 + 31) {
#pragma unroll 1
        for (int kp = 0; kp < 2; ++kp) {
          f32x4 S[2][2]; zero_acc(S);
#pragma unroll
          for (int k2 = 0; k2 < 2; ++k2)
#pragma unroll
            for (int ks = 0; ks < 4; ++ks) {
              const bf16x8 a = *(const bf16x8*)(Bts + (kp * 32 + k2 * 16 + l15) * 136 + ks * 32 + q * 8);
#pragma unroll
              for (int nt = 0; nt < 2; ++nt) S[k2][nt] = mfma16(a, Cf[nt][ks], S[k2][nt]);
            }
#pragma unroll
          for (int k2 = 0; k2 < 2; ++k2) {
            const int s0 = sb * 64 + kp * 32 + k2 * 16 + q * 4;
            const float4 as4 = *(const float4*)(acs + s0); const float4 dt4 = *(const float4*)(dts + s0);
            const float asv[4] = {as4.x, as4.y, as4.z, as4.w}; const float dtv4[4] = {dt4.x, dt4.y, dt4.z, dt4.w};
#pragma unroll
            for (int nt = 0; nt < 2; ++nt)
#pragma unroll
              for (int j = 0; j < 4; ++j) {
                const int sidx = s0 + j;
                float v = (sidx <= lrow[nt]) ? S[k2][nt][j] * __expf(acl[nt] - asv[j]) * dtv4[j] : 0.f;
                if (sidx == lrow[nt]) v += Dh;
                S[k2][nt][j] = v;
              }
          }
          bf16x8 P[2];
#pragma unroll
          for (int nt = 0; nt < 2; ++nt)
            P[nt] = as_bf16x8(pack2(S[0][nt][0], S[0][nt][1]), pack2(S[0][nt][2], S[0][nt][3]), pack2(S[1][nt][0], S[1][nt][1]), pack2(S[1][nt][2], S[1][nt][3]));
#pragma unroll
          for (int dt = 0; dt < 4; ++dt) {
            const u16* sx = Xts + (kp * 32 + q * 4 + (l15 >> 2)) * 72 + dt * 16 + (l15 & 3) * 4;
            const bf16x8 a = tr_frag(sx, sx + 16 * 72);
#pragma unroll
            for (int nt = 0; nt < 2; ++nt) O[dt][nt] = mfma16(a, P[nt], O[dt][nt]);
          }
        }
      }
    }
#pragma unroll
    for (int nt = 0; nt < 2; ++nt) {
      const size_t rowoff = (size_t)(rb + lrow[nt]) * 1024 + h * 64;
      float ss = 0.f;
#pragma unroll
      for (int dt = 0; dt < 4; ++dt) {
        u16* zp = p.zs + rowoff + dt * 16 + q * 4;
        const U2 zv = *(const U2*)zp;
        const float v0 = O[dt][nt][0] * lo_f(zv.x), v1 = O[dt][nt][1] * hi_f(zv.x), v2 = O[dt][nt][2] * lo_f(zv.y), v3 = O[dt][nt][3] * hi_f(zv.y);
        ss += v0 * v0 + v1 * v1 + v2 * v2 + v3 * v3;
        U2 o; o.x = pack2(v0, v1); o.y = pack2(v2, v3);
        if (rep) *(U2*)zp = o;
      }
      ss += __shfl_xor(ss, 16, 64); ss += __shfl_xor(ss, 32, 64);
      if (q == 0 && rep) p.ssq[(size_t)(rb + lrow[nt]) * 16 + h] = ss;
    }
  }
}

template <int MODE>
DI void attn_pass(unsigned char* smem, const u16* Kg, const u16* VTg, int ldv, int jb0, int jb1, u64 act0, u64 act1,
                  const bf16x8 (&Qf)[4][2], float (&m)[4], float (&ls)[4], f32x4 (&O)[4][4],
                  const int (&lo)[4], const int (&hi)[4], const u64* selrow  ,
                  const float (&invL)[4], float* imp_row  ) {
  u16* Ks = (u16*)smem; u16* Vs = Ks + 64 * 72;
  const int tid = otid(), lane = tid & 63, l15 = lane & 15, q = lane >> 4;
  U4 rk[2], rv[2];
  int jb = jb0;
  while (jb <= jb1 && !(((jb < 64 ? (act0 >> jb) : (act1 >> (jb - 64))) & 1ull))) ++jb;
  if (jb > jb1) return;
#pragma unroll
  for (int i = 0; i < 2; ++i) {
    const int ci = tid + i * 256; const int row = ci >> 3, cc = ci & 7;
    rk[i] = *(const U4*)(Kg + (size_t)(jb * 64 + row) * 64 + cc * 8);
    if (MODE != 1) rv[i] = *(const U4*)(VTg + (size_t)row * ldv + jb * 64 + cc * 8);
  }
  float carry[4] = {0.f, 0.f, 0.f, 0.f};
  while (jb <= jb1) {
    __syncthreads();
#pragma unroll
    for (int i = 0; i < 2; ++i) {
      const int ci = tid + i * 256; const int row = ci >> 3, cc = ci & 7;
      *(U4*)(Ks + row * 72 + cc * 8) = rk[i];
      if (MODE != 1) *(U4*)(Vs + row * 72 + cc * 8) = rv[i];
    }
    __syncthreads();
    int nj = jb + 1;
    while (nj <= jb1 && !(((nj < 64 ? (act0 >> nj) : (act1 >> (nj - 64))) & 1ull))) ++nj;
    if (nj <= jb1) {
#pragma unroll
      for (int i = 0; i < 2; ++i) {
        const int ci = tid + i * 256; const int row = ci >> 3, cc = ci & 7;
        rk[i] = *(const U4*)(Kg + (size_t)(nj * 64 + row) * 64 + cc * 8);
        if (MODE != 1) rv[i] = *(const U4*)(VTg + (size_t)row * ldv + nj * 64 + cc * 8);
      }
    }
    bool rowok[4]; unsigned need = 0u; bool allin = true;
#pragma unroll
    for (int nt = 0; nt < 4; ++nt) {
      rowok[nt] = selrow ? (((selrow[nt * 8 + (jb >> 6)] >> (jb & 63)) & 1ull) != 0) : true;
      if (__ballot(rowok[nt]) != 0ull) need |= 1u << nt;
      allin = allin && (lo[nt] <= jb * 64) && (jb * 64 + 63 <= hi[nt]);
    }
    const bool interior = (__ballot(!allin) == 0ull);
    if (need != 0u) {
#pragma unroll 1
    for (int half = 0; half < 2; ++half) {
      const int kbase = jb * 64 + half * 32;
      bf16x8 ka[2][2], va[4];
#pragma unroll
      for (int kt2 = 0; kt2 < 2; ++kt2) {
        const u16* kr = Ks + (half * 32 + kt2 * 16 + l15) * 72 + q * 8;
        ka[kt2][0] = *(const bf16x8*)kr; ka[kt2][1] = *(const bf16x8*)(kr + 32);
      }
      if (MODE != 1) {
#pragma unroll
        for (int dt = 0; dt < 4; ++dt) {
          const u16* vr = Vs + (dt * 16 + l15) * 72 + half * 32 + q * 4;
          const U2 v0 = *(const U2*)vr; const U2 v1 = *(const U2*)(vr + 16);
          va[dt] = as_bf16x8(v0.x, v0.y, v1.x, v1.y);
        }
      }
#pragma unroll
      for (int nt = 0; nt < 4; ++nt) {
        if (need & (1u << nt)) {
          f32x4 S[2];
#pragma unroll
          for (int kt2 = 0; kt2 < 2; ++kt2) {
            S[kt2] = mfma16(ka[kt2][0], Qf[nt][0], f32x4{0.f, 0.f, 0.f, 0.f});
            S[kt2] = mfma16(ka[kt2][1], Qf[nt][1], S[kt2]);
          }
          if (!interior) {
#pragma unroll
            for (int kt2 = 0; kt2 < 2; ++kt2)
#pragma unroll
              for (int j = 0; j < 4; ++j) {
                const int kp = kbase + kt2 * 16 + q * 4 + j;
                S[kt2][j] = (kp >= lo[nt] && kp <= hi[nt]) ? S[kt2][j] : -__builtin_inff();
              }
          }
          if (MODE != 2) {
            float ml;
            {
              const float r1 = max3_f(S[0][0], S[0][1], S[0][2]), r2 = max3_f(S[0][3], S[1][0], S[1][1]), r3 = max3_f(S[1][2], S[1][3], S[1][3]);
              ml = max3_f(r1, r2, r3);
            }
            ml = rowok[nt] ? ml : -__builtin_inff();
            if (__ballot(ml > m[nt] + 8.f) != 0ull) {
              const float mx = quad_max(max3_f(ml, m[nt], m[nt]));
              const float alpha = exp2_f(m[nt] - mx);
              m[nt] = mx;
              ls[nt] *= alpha;
              if (MODE == 0) {
#pragma unroll
                for (int dt = 0; dt < 4; ++dt) O[dt][nt] *= alpha;
              }
            }
            const float neg = rowok[nt] ? m[nt] : __builtin_inff();
#pragma unroll
            for (int kt2 = 0; kt2 < 2; ++kt2)
#pragma unroll
              for (int j = 0; j < 4; ++j) S[kt2][j] = exp2_f(S[kt2][j] - neg);
            ls[nt] += ((S[0][0] + S[0][1]) + (S[0][2] + S[0][3])) + ((S[1][0] + S[1][1]) + (S[1][2] + S[1][3]));
          } else {
            float own = 0.f;
#pragma unroll
            for (int kt2 = 0; kt2 < 2; ++kt2)
#pragma unroll
              for (int j = 0; j < 4; ++j) S[kt2][j] = exp2_f(S[kt2][j] - m[nt]) * invL[nt];
#pragma unroll
            for (int kt2 = 0; kt2 < 2; ++kt2) {
              own = (S[kt2][0] + S[kt2][1]) + (S[kt2][2] + S[kt2][3]);
              float last = S[kt2][3];
              own += __shfl_xor(own, 1, 64); own += __shfl_xor(own, 2, 64);
              last += __shfl_xor(last, 1, 64); last += __shfl_xor(last, 2, 64);
              const float up = __shfl(last, (lane + 48) & 63, 64);
              const float nb = (q > 0) ? up : carry[nt];
              carry[nt] = up;
              if ((l15 & 3) == 0) imp_row[nt * 512 + ((kbase + kt2 * 16) >> 2) + q] = own + nb;
            }
          }
          if (MODE != 1) {
            const bf16x8 P = as_bf16x8(pack2(S[0][0], S[0][1]), pack2(S[0][2], S[0][3]), pack2(S[1][0], S[1][1]), pack2(S[1][2], S[1][3]));
#pragma unroll
            for (int dt = 0; dt < 4; ++dt) O[dt][nt] = mfma16(va[dt], P, O[dt][nt]);
          }
        }
      }
    }
    }
    jb = nj;
  }
}

DI void accum_lds(unsigned* otl, const f32x4 (&O)[4][4], const float (&sc)[4], bool first) {
  const int lane = threadIdx.x & 63;
#pragma unroll
  for (int dt = 0; dt < 4; ++dt)
#pragma unroll
    for (int nt = 0; nt < 4; ++nt) {
      float v0 = O[dt][nt][0] * sc[nt], v1 = O[dt][nt][1] * sc[nt], v2 = O[dt][nt][2] * sc[nt], v3 = O[dt][nt][3] * sc[nt];
      unsigned* a = otl + ((dt * 4 + nt) * 2) * 64 + lane;
      if (!first) { const unsigned p0 = a[0], p1 = a[64]; v0 += lo_f(p0); v1 += hi_f(p0); v2 += lo_f(p1); v3 += hi_f(p1); }
      a[0] = pack2(v0, v1); a[64] = pack2(v2, v3);
    }
}

DI void attn_item(const Params& p, int cur, int bg, unsigned char* smem, int rep) {
  const int tid = otid(), lane = tid & 63, wave = tid >> 6, l15 = lane & 15, q = lane >> 4;
  const int b = bg >> 2, g = bg & 3;
  const int tl = l15 >> 2, hd = l15 & 3;
  float* imp = (float*)(smem + 18432);
  u64* sel = (u64*)(smem + 18432 + 32768);
  u64* uni = sel + 128;
  const int tokl0 = wave * 16 + tl;
  const int t0 = cur * 64 + tokl0;
  const size_t row0 = (size_t)b * SEQ + t0;
  bf16x8 Qf[4][2];
#pragma unroll
  for (int nt = 0; nt < 4; ++nt)
#pragma unroll
    for (int ks = 0; ks < 2; ++ks) Qf[nt][ks] = *(const bf16x8*)(p.q + (row0 + nt * 4) * 1024 + (g * 4 + hd) * 64 + ks * 32 + q * 8);
  float m[4], ls[4], invL[4], sc[4]; f32x4 O[4][4];
  int lo[4], hi[4];
  unsigned* otl = (unsigned*)imp + wave * 2048;
  const u64 ALL = ~0ull;
  {
  const u16* kcg = p.kc + (size_t)bg * 512 * 64; const u16* vcg = p.vcT + (size_t)bg * 64 * 512;
  const int nkb = ((4 * cur + 2) >> 6) + 1;
#pragma unroll
  for (int nt = 0; nt < 4; ++nt) { m[nt] = -1e30f; ls[nt] = 0.f; invL[nt] = 0.f; lo[nt] = 0; hi[nt] = (t0 + nt * 4 - 31) >> 4; }
  zero_acc(O);
  attn_pass<1>(smem, kcg, vcg, 512, 0, nkb - 1, ALL, ALL, Qf, m, ls, O, lo, hi, nullptr, invL, nullptr);
#pragma unroll
  for (int nt = 0; nt < 4; ++nt) {
    const float L = quad_sum(ls[nt]);
    invL[nt] = (L > 0.f) ? 1.f / L : 0.f;
  }
  attn_pass<2>(smem, kcg, vcg, 512, 0, nkb - 1, ALL, ALL, Qf, m, ls, O, lo, hi, nullptr, invL, imp + tokl0 * 128);
#pragma unroll
  for (int nt = 0; nt < 4; ++nt) sc[nt] = p.gates[(row0 + nt * 4) * 48 + (g * 4 + hd) * 3 + 0];
  __syncthreads();
  {
    u64 un0 = 0, un1 = 0;
    const u64 v0m = (cur >= 63) ? ALL : ((1ull << (cur + 1)) - 1ull);
    const u64 v1m = (cur < 64) ? 0ull : ((cur >= 127) ? ALL : ((1ull << (cur - 63)) - 1ull));
    const u64 lowm = (1ull << lane) - 1ull;
    for (int tk = 0; tk < 16; ++tk) {
      const float* rowp = imp + (wave * 16 + tk) * 128;
      const int j0 = lane, j1 = lane + 64;
      unsigned k0 = 0u, k1 = 0u;
      if (j0 <= cur) k0 = (j0 == 0 || j0 == cur || j0 == cur - 1) ? 0x7F800000u : __float_as_uint(rowp[j0]);
      if (j1 <= cur) k1 = (j1 == cur || j1 == cur - 1) ? 0x7F800000u : __float_as_uint(rowp[j1]);
      unsigned T = 0u;
      for (int bit = 30; bit >= 0; --bit) {
        const unsigned cand = T | (1u << bit);
        const int cnt = __popcll(__ballot(k0 >= cand)) + __popcll(__ballot(k1 >= cand));
        if (cnt >= 16) T = cand;
      }
      const u64 gt0 = __ballot(k0 > T), gt1 = __ballot(k1 > T);
      const int needn = 16 - (__popcll(gt0) + __popcll(gt1));
      const u64 eq0 = __ballot(k0 == T), eq1 = __ballot(k1 == T);
      const int r0 = __popcll(eq0 & lowm), r1 = __popcll(eq0) + __popcll(eq1 & lowm);
      const bool s0 = (k0 > T) || (k0 == T && r0 < needn);
      const bool s1 = (k1 > T) || (k1 == T && r1 < needn);
      const u64 b0 = __ballot(s0) & v0m, b1 = __ballot(s1) & v1m;
      if (lane == 0) { sel[(wave * 16 + tk) * 2] = b0; sel[(wave * 16 + tk) * 2 + 1] = b1; }
      un0 |= b0; un1 |= b1;
    }
    if (lane == 0) { uni[wave * 2] = un0; uni[wave * 2 + 1] = un1; }
  }
  accum_lds(otl, O, sc, true);
  __syncthreads();
  const u64 act0 = uni[0] | uni[2] | uni[4] | uni[6], act1 = uni[1] | uni[3] | uni[5] | uni[7];
#pragma unroll
  for (int nt = 0; nt < 4; ++nt) { m[nt] = -1e30f; ls[nt] = 0.f; lo[nt] = 0; hi[nt] = t0 + nt * 4; }
  zero_acc(O);
  attn_pass<0>(smem, p.kslc + (size_t)bg * SEQ * 64, p.vslcT + (size_t)bg * 64 * SEQ, SEQ, 0, cur, act0, act1, Qf, m, ls, O, lo, hi, sel + tokl0 * 2, invL, nullptr);
#pragma unroll
  for (int nt = 0; nt < 4; ++nt) {
    const float L = quad_sum(ls[nt]);
    sc[nt] = (L > 0.f) ? p.gates[(row0 + nt * 4) * 48 + (g * 4 + hd) * 3 + 1] / L : 0.f;
  }
  accum_lds(otl, O, sc, false);
#pragma unroll
  for (int nt = 0; nt < 4; ++nt) { m[nt] = -1e30f; ls[nt] = 0.f; lo[nt] = t0 + nt * 4 - 511; hi[nt] = t0 + nt * 4; }
  zero_acc(O);
  attn_pass<0>(smem, p.kwin + (size_t)bg * SEQ * 64, p.vwinT + (size_t)bg * 64 * SEQ, SEQ, (cur >= 8 ? cur - 8 : 0), cur, ALL, ALL, Qf, m, ls, O, lo, hi, nullptr, invL, nullptr);
#pragma unroll
  for (int nt = 0; nt < 4; ++nt) {
    const float L = quad_sum(ls[nt]);
    sc[nt] = (L > 0.f) ? p.gates[(row0 + nt * 4) * 48 + (g * 4 + hd) * 3 + 2] / L : 0.f;
  }
  accum_lds(otl, O, sc, false);
  if (rep == 1)
#pragma unroll
  for (int nt = 0; nt < 4; ++nt)
#pragma unroll
    for (int dt = 0; dt < 4; ++dt) {
      u16* zp = p.za + (row0 + nt * 4) * 1024 + (g * 4 + hd) * 64 + dt * 16 + q * 4;
      const U2 zv = *(const U2*)zp;
      const unsigned* a = otl + ((dt * 4 + nt) * 2) * 64 + lane;
      const unsigned p0 = a[0], p1 = a[64];
      U2 o;
      o.x = pack2(lo_f(p0) * lo_f(zv.x), hi_f(p0) * hi_f(zv.x));
      o.y = pack2(lo_f(p1) * lo_f(zv.y), hi_f(p1) * hi_f(zv.y));
      *(U2*)zp = o;
    }
  }
}

DI void gemm2_tile(const Params& p, int mt_i, int nt_i, unsigned char* smem) {
  const int m0 = mt_i * 128, n0 = nt_i * 128;
  const int tid = otid(), lane = tid & 63, wave = tid >> 6, wm = wave >> 1, wn = wave & 1, l15 = lane & 15, q = lane >> 4;
  float* rinv = (float*)(smem + 65536 + 64);
  __syncthreads();
  if (tid < 128) {
    const float* sp = p.ssq + (size_t)(m0 + tid) * 16;
    float tot = 0.f;
    for (int k = 0; k < 16; ++k) tot += sp[k];
    rinv[tid] = rsqrtf(tot * (1.f / 1024.f) + EPS);
  }
  f32x4 acc[4][4], res[4][4]; unsigned gte[4][4][2];
  zero_acc(res);
#pragma unroll 1
  for (int br = 0; br < 2; ++br) {
    zero_acc(acc);
    gemm_core<4, 4>(p.hbf + (size_t)m0 * LDH, LDH, p.wt + (size_t)(NG1 + br * 1024 + n0) * LDH, LDH, DM, acc, (u16*)smem);
#pragma unroll
    for (int a = 0; a < 4; ++a)
#pragma unroll
      for (int c = 0; c < 4; ++c) {
        gte[a][c][0] = pack2(sigmoid_f(acc[a][c][0]), sigmoid_f(acc[a][c][1]));
        gte[a][c][1] = pack2(sigmoid_f(acc[a][c][2]), sigmoid_f(acc[a][c][3]));
      }
    zero_acc(acc);
    gemm_core<4, 4>((br ? p.za : p.zs) + (size_t)m0 * DM, DM, (br ? p.wba_t : p.wbs_t) + (size_t)n0 * DM, DM, DM, acc, (u16*)smem);
#pragma unroll
    for (int a = 0; a < 4; ++a) {
      float r[4];
#pragma unroll
      for (int j = 0; j < 4; ++j) r[j] = br ? 1.f : rinv[wm * 64 + a * 16 + q * 4 + j];
#pragma unroll
      for (int c = 0; c < 4; ++c) {
        res[a][c][0] += lo_f(gte[a][c][0]) * r[0] * acc[a][c][0];
        res[a][c][1] += hi_f(gte[a][c][0]) * r[1] * acc[a][c][1];
        res[a][c][2] += lo_f(gte[a][c][1]) * r[2] * acc[a][c][2];
        res[a][c][3] += hi_f(gte[a][c][1]) * r[3] * acc[a][c][3];
      }
    }
  }
  u16* mg = p.q;
#pragma unroll
  for (int a = 0; a < 4; ++a)
#pragma unroll
    for (int c = 0; c < 4; ++c)
#pragma unroll
      for (int j = 0; j < 4; ++j) {
        const int row = m0 + wm * 64 + a * 16 + q * 4 + j; const int col = n0 + wn * 64 + c * 16 + l15;
        mg[(size_t)row * DM + col] = f2bf(res[a][c][j]);
      }
}

DI float dpp_x1(float v) { return __builtin_bit_cast(float, __builtin_amdgcn_update_dpp(0, __builtin_bit_cast(int, v), 0xB1, 0xF, 0xF, true)); }
DI void gemm3_tile(const Params& p, int mt_i, int nt_i, unsigned char* smem) {
  const int m0 = mt_i * 128, n0 = nt_i * 128;
  const int tid = otid(), lane = tid & 63, wave = tid >> 6, wm = wave >> 1, wn = wave & 1, l15 = lane & 15, q = lane >> 4;
  f32x4 acc[4][4]; zero_acc(acc);
  gemm_core<4, 4>(p.q + (size_t)m0 * DM, DM, p.wout_t + (size_t)n0 * DM, DM, DM, acc, (u16*)smem);
  const bool odd = (l15 & 1) != 0;
  const int cpair = l15 & ~1;
#pragma unroll
  for (int mt = 0; mt < 4; ++mt) {
    float ss0 = 0.f, ss1 = 0.f;
    const int rowA = m0 + wm * 64 + mt * 16 + q * 4 + (odd ? 1 : 0);
#pragma unroll
    for (int nt = 0; nt < 4; ++nt) {
      float pp[4];
#pragma unroll
      for (int j = 0; j < 4; ++j) pp[j] = dpp_x1(acc[mt][nt][j]);
      const float a0 = odd ? pp[1] : acc[mt][nt][0], a1 = odd ? acc[mt][nt][1] : pp[0];
      const float b0 = odd ? pp[3] : acc[mt][nt][2], b1 = odd ? acc[mt][nt][3] : pp[2];
      const int col = n0 + wn * 64 + nt * 16 + cpair;
      const f32x2 xa = __builtin_nontemporal_load((const f32x2*)(p.x + (size_t)rowA * DM + col));
      const f32x2 xb = __builtin_nontemporal_load((const f32x2*)(p.x + (size_t)(rowA + 2) * DM + col));
      const f32x2 va = {a0 + xa[0], a1 + xa[1]}, vb = {b0 + xb[0], b1 + xb[1]};
      *(f32x2*)(p.out + (size_t)rowA * DM + col) = va;
      *(f32x2*)(p.out + (size_t)(rowA + 2) * DM + col) = vb;
      ss0 += va[0] * va[0] + va[1] * va[1];
      ss1 += vb[0] * vb[0] + vb[1] * vb[1];
    }
    ss0 += __shfl_xor(ss0, 2, 64); ss0 += __shfl_xor(ss0, 4, 64); ss0 += __shfl_xor(ss0, 8, 64);
    ss1 += __shfl_xor(ss1, 2, 64); ss1 += __shfl_xor(ss1, 4, 64); ss1 += __shfl_xor(ss1, 8, 64);
    if (l15 < 2) {
      p.ssq2[(size_t)rowA * 16 + nt_i * 2 + wn] = ss0;
      p.ssq2[(size_t)(rowA + 2) * 16 + nt_i * 2 + wn] = ss1;
    }
  }
}

struct BarState { unsigned epoch, myx, nx_wg, n_xcc; };
DI unsigned xcc_id() { return (unsigned)__builtin_amdgcn_s_getreg((3 << 11) | 20) & 0xFu; }
DI void grid_barrier(unsigned* ctl, BarState& st) {
  st.epoch += 1;
  const unsigned epoch = st.epoch;
  __syncthreads();
  if (threadIdx.x < 64) {
    unsigned last = 0u;
    if (threadIdx.x == 0) {
      if (epoch == 1u) {
        __builtin_amdgcn_fence(__ATOMIC_RELEASE, "agent");
        const unsigned v = __hip_atomic_fetch_add(ctl, 1u, __ATOMIC_RELAXED, __HIP_MEMORY_SCOPE_AGENT) + 1u;
        last = (v == gridDim.x) ? 1u : 0u;
      } else {
        const unsigned a = __hip_atomic_fetch_add(ctl + 256 + st.myx * 32, 1u, __ATOMIC_RELAXED, __HIP_MEMORY_SCOPE_AGENT) + 1u;
        if (a == (epoch - 1u) * st.nx_wg) {
          __builtin_amdgcn_fence(__ATOMIC_RELEASE, "agent");
          const unsigned v = __hip_atomic_fetch_add(ctl + 32, 1u, __ATOMIC_RELAXED, __HIP_MEMORY_SCOPE_AGENT) + 1u;
          last = (v == (epoch - 1u) * st.n_xcc) ? 1u : 0u;
        }
      }
    }
    last = (unsigned)__builtin_amdgcn_readfirstlane((int)last);
    if (last) {
      __builtin_amdgcn_fence(__ATOMIC_ACQUIRE, "agent");
      __builtin_amdgcn_fence(__ATOMIC_RELEASE, "agent");
      for (unsigned g = threadIdx.x; g < ((gridDim.x + 7u) >> 3); g += 64u) __hip_atomic_store(ctl + 1008 + g * 32, epoch, __ATOMIC_RELAXED, __HIP_MEMORY_SCOPE_AGENT);
    }
    if (threadIdx.x == 0) {
      unsigned* f = ctl + 1008 + (blockIdx.x >> 3) * 32;
      while (__hip_atomic_load(f, __ATOMIC_RELAXED, __HIP_MEMORY_SCOPE_AGENT) < epoch) __builtin_amdgcn_s_sleep(64);
      __builtin_amdgcn_fence(__ATOMIC_ACQUIRE, "agent");
      if (epoch == 1u) {
        st.nx_wg = __hip_atomic_load(ctl + 768 + st.myx * 8, __ATOMIC_RELAXED, __HIP_MEMORY_SCOPE_AGENT);
        unsigned n = 0u;
        for (int x = 0; x < 16; ++x) n += (__hip_atomic_load(ctl + 768 + x * 8, __ATOMIC_RELAXED, __HIP_MEMORY_SCOPE_AGENT) != 0u) ? 1u : 0u;
        st.n_xcc = n;
      }
    }
  }
  __syncthreads();
}

__global__ void __launch_bounds__(256, 2) hybrid_fwd(Params p) {
  cg::grid_group grid = cg::this_grid();
  extern __shared__ __attribute__((aligned(16))) unsigned char smem[];
  const int tid = threadIdx.x;
  BarState epoch{}; unsigned* bar = p.counter + 16;
  epoch.myx = xcc_id();
  if (tid == 0) __hip_atomic_fetch_add(bar + 768 + epoch.myx * 8, 1u, __ATOMIC_RELAXED, __HIP_MEMORY_SCOPE_AGENT);
  if (p.counter == nullptr) grid.sync();
  grid_barrier(bar, epoch);
  phase0(p, smem);
#ifdef PROBE_P0X2
  phase0(p, smem);
#endif
  grid_barrier(bar, epoch);
  patch_walk<16, 4>(128, 52, [&](int mt, int nt) { gemm1_tile(p, mt, nt, smem); });
  for (int t = blockIdx.x; t < 256; t += gridDim.x) gemm1_mini_tile(p, t, smem);
#ifdef PROBE_G1X2
  patch_walk(128, 53, [&](int mt, int nt) { gemm1_tile(p, mt, nt, smem); });
#endif
  grid_barrier(bar, epoch);
  for (int t = blockIdx.x; t < 512; t += gridDim.x) preconv_item(p, t);
  grid_barrier(bar, epoch);
  {
    int* s_item = (int*)(smem + 65536);
    for (;;) {
      __syncthreads();
      if (tid == 0) *s_item = (int)atomicAdd(p.counter + 9, 1u);
      __syncthreads();
      const int t = *s_item;
      if (t >= 256 + 1024) break;
      if (t < 256) cmp_a_tile(p, t, smem); else ssd_states_item(p, t - 256, smem);
    }
  }
  grid_barrier(bar, epoch);
#ifdef PROBE_P37X2
  for (int t = blockIdx.x; t < 64 + 256; t += gridDim.x) {
    if (t < 64) cmp_b_tile(p, t, smem);
    else {
      const int e4 = (t - 64) * 256 + threadIdx.x; const int b = e4 >> 15, h = (e4 >> 11) & 15, r = e4 & 2047;
      float4* st = (float4*)p.states;
      for (int c = 0; c < 32; ++c) { const size_t idx = (size_t)((b * 32 + c) * 16 + h) * 2048 + r; float4 v = st[idx]; v.x += 0.f; st[idx] = v; }
    }
  }
#endif
  for (int t = blockIdx.x; t < 64 + 256; t += gridDim.x) { if (t < 64) cmp_b_tile(p, t, smem); else scan_item(p, t - 64); }
  grid_barrier(bar, epoch);
  {
    int* s_item = (int*)(smem + 65536);
#ifndef SKIP_ATTN
    for (;;) {
      __syncthreads();
      if (tid == 0) *s_item = (int)atomicAdd(p.counter + (blockIdx.x & 7), 1u);
      __syncthreads();
      const int item = *s_item;
#ifdef PROBE_ATTNX2
      if (item >= 256) break;
      attn_item(p, 127 - (item >> 1), blockIdx.x & 7, smem, item & 1);
#else
      if (item >= 128) break;
      attn_item(p, 127 - item, blockIdx.x & 7, smem, 1);
#endif
    }
#endif
#ifndef SKIP_SSDY
    for (;;) {
      __syncthreads();
      if (tid == 0) *s_item = (int)atomicAdd(p.counter + 8, 1u);
      __syncthreads();
      const int item = *s_item;
#ifdef PROBE_SSDYX2
      if (item >= 2048) break;
      ssd_y_item(p, item & 1023, smem, item >> 10);
#else
      if (item >= 1024) break;
      ssd_y_item(p, item, smem, 1);
#endif
    }
#endif
  }
  grid_barrier(bar, epoch);
  patch_walk(128, 8, [&](int mt, int nt) { gemm2_tile(p, mt, nt, smem); });
  grid_barrier(bar, epoch);
  patch_walk(128, 8, [&](int mt, int nt) { gemm3_tile(p, mt, nt, smem); });
  grid_barrier(bar, epoch);
#ifdef PROBE_SYNCX
  for (int i = 0; i < 10; ++i) grid_barrier(bar, epoch);
#endif
  {
    const int lane = tid & 63, wave = tid >> 6;
#ifdef PROBE_P37X2
    for (int it = blockIdx.x; it < NTOK / 4; it += gridDim.x) {
      const int row = it * 4 + wave;
      float4* o = (float4*)(p.out + (size_t)row * DM);
      for (int k = 0; k < 4; ++k) { float4 v = o[lane + 64 * k]; v.x += 0.f; o[lane + 64 * k] = v; }
    }
    __syncthreads();
#endif
    for (int it = blockIdx.x; it < NTOK / 4; it += gridDim.x) {
      const int row = it * 4 + wave;
      const float4* sp = (const float4*)(p.ssq2 + (size_t)row * 16);
      const float4 s0 = sp[0], s1 = sp[1], s2 = sp[2], s3 = sp[3];
      const float tot = ((s0.x + s0.y) + (s0.z + s0.w)) + ((s1.x + s1.y) + (s1.z + s1.w)) + ((s2.x + s2.y) + (s2.z + s2.w)) + ((s3.x + s3.y) + (s3.z + s3.w));
      const float r = rsqrtf(tot * (1.f / 1024.f) + EPS);
      float4* o = (float4*)(p.out + (size_t)row * DM);
#pragma unroll
      for (int k = 0; k < 4; ++k) {
        float4 v = o[lane + 64 * k]; const float4 w = ((const float4*)p.final_w)[lane + 64 * k];
        v.x *= r * w.x; v.y *= r * w.y; v.z *= r * w.z; v.w *= r * w.w;
        __builtin_nontemporal_store(f32x4{v.x, v.y, v.z, v.w}, (f32x4*)o + lane + 64 * k);
      }
    }
  }
}

extern "C" void kernel_launch(void* const* d_in, const int* in_sizes, int n_in, void* d_out, int out_size, void* d_ws, size_t ws_size, hipStream_t stream) {
  static int grid_blocks = 0;
  if (!grid_blocks) {
    int dev = 0, cus = 0, per_cu = 0;
    hipGetDevice(&dev);
    hipDeviceGetAttribute(&cus, hipDeviceAttributeMultiprocessorCount, dev);
    hipFuncSetAttribute((const void*)hybrid_fwd, hipFuncAttributeMaxDynamicSharedMemorySize, SMEM_DYN);
    hipOccupancyMaxActiveBlocksPerMultiprocessor(&per_cu, hybrid_fwd, 256, SMEM_DYN);
    if (per_cu < 1) per_cu = 1;
    if (per_cu > 2) per_cu = 2;
    grid_blocks = cus * per_cu;
    if (grid_blocks > 768) grid_blocks = 768;
    grid_blocks &= ~7;
  }
  Params p{};
  const float* const* in = (const float* const*)d_in;
  p.x = in[0]; p.norm_w = in[1]; p.w_in = in[2]; p.conv_w = in[3]; p.conv_b = in[4]; p.dt_bias = in[5]; p.a_log = in[6]; p.d_skip = in[7];
  p.ssm_norm_w = in[8]; p.cmp_pos_k = in[9]; p.cmp_pos_v = in[10]; p.ck_w1 = in[11]; p.ck_b1 = in[12]; p.ck_w2 = in[13];
  p.cv_w1 = in[14]; p.cv_b1 = in[15]; p.cv_w2 = in[16]; p.w_bs = in[17]; p.w_ba = in[18]; p.w_out = in[19]; p.final_w = in[20];
  p.out = (float*)d_out;
  p.xbc = (u16*)d_out;
  unsigned char* w = (unsigned char*)d_ws; size_t off = 0;
  auto take = [&](size_t bytes) { unsigned char* r = w + off; off += (bytes + 255) & ~(size_t)255; return r; };
  p.hbf = (u16*)take((size_t)NTOK * LDH * 2);
  p.wt = (u16*)take((size_t)WT_ROWS * LDH * 2);
  p.wbs_t = (u16*)take((size_t)DM * DM * 2); p.wba_t = (u16*)take((size_t)DM * DM * 2); p.wout_t = (u16*)take((size_t)DM * DM * 2);
  p.w1k_t = (u16*)take((size_t)256 * 2048 * 2); p.w1v_t = (u16*)take((size_t)256 * 2048 * 2);
  p.w2k_t = (u16*)take((size_t)64 * 256 * 2); p.w2v_t = (u16*)take((size_t)64 * 256 * 2);
  p.zs = (u16*)take((size_t)NTOK * DM * 2);
  p.q = (u16*)take((size_t)NTOK * DM * 2);
  const size_t kvb = (size_t)NTOK * 256 * 2;
  p.kcmp = (u16*)take(kvb); p.vcmp = (u16*)take(kvb); p.kslc = (u16*)take(kvb); p.vslcT = (u16*)take(kvb); p.kwin = (u16*)take(kvb); p.vwinT = (u16*)take(kvb);
  p.za = (u16*)take((size_t)NTOK * DM * 2);
  p.states = (float*)take((size_t)2 * 32 * 16 * 8192 * 4);
  p.hid_k = (u16*)take((size_t)4096 * 256 * 2); p.hid_v = (u16*)take((size_t)4096 * 256 * 2);
  p.kc = (u16*)take((size_t)8 * 512 * 64 * 2); p.vcT = (u16*)take((size_t)8 * 64 * 512 * 2);
  p.gates = (float*)take((size_t)NTOK * 48 * 4);
  p.dtv = (float*)take((size_t)NTOK * 16 * 4);
  p.ssq = (float*)take((size_t)NTOK * 16 * 4); p.ssq2 = (float*)take((size_t)NTOK * 16 * 4);
  p.rope = (float*)take((size_t)SEQ * 32 * 2 * 4);
  p.peb = (float*)take(64 * 256 * 4);
  p.cd = (float*)take(2 * 32 * 16 * 4);
  p.counter = (unsigned*)take(16384);
  if (off > ws_size) { fprintf(stderr, "kernel_launch: workspace too small: need %zu, have %zu\n", off, ws_size); return; }
  if (hipMemsetAsync(p.counter, 0, 16384, stream) != hipSuccess) { fprintf(stderr, "kernel_launch: memset of control words failed\n"); return; }
  void* args[] = {&p};
  hipError_t e = hipLaunchCooperativeKernel((void*)hybrid_fwd, dim3(grid_blocks), dim3(256), args, SMEM_DYN, stream);
  if (e != hipSuccess) fprintf(stderr, "cooperative launch failed: %s (grid %d)\n", hipGetErrorString(e), grid_blocks);
}
```

```cpp
#include <hip/hip_runtime.h>
#include <hip/hip_cooperative_groups.h>
#include <cstdio>
namespace cg = cooperative_groups;

typedef unsigned short u16;
typedef unsigned long long u64;
typedef __attribute__((ext_vector_type(8))) short bf16x8;
typedef __attribute__((ext_vector_type(4))) float f32x4;
typedef __attribute__((ext_vector_type(4))) unsigned u32x4;
typedef __attribute__((ext_vector_type(4))) unsigned U4;
typedef __attribute__((ext_vector_type(2))) unsigned U2;
#define DI __device__ __forceinline__

#define NTOK 16384
#define SEQ 8192
#define DM 1024
#define IN_TOTAL 8768
#define NG1 6784
#define WT_ROWS 8832
#define EPS 1e-6f
#define LDH 1152
#define SMEM_BYTES 57344
#define SMEM_DYN (65536 + 1024)
#define RESCALE_SKIP 1

struct Params {
  const float *x, *norm_w, *w_in, *conv_w, *conv_b, *dt_bias, *a_log, *d_skip, *ssm_norm_w, *cmp_pos_k, *cmp_pos_v;
  const float *ck_w1, *ck_b1, *ck_w2, *cv_w1, *cv_b1, *cv_w2, *w_bs, *w_ba, *w_out, *final_w;
  float* out;
  u16 *hbf, *wt, *wbs_t, *wba_t, *wout_t, *w1k_t, *w1v_t, *w2k_t, *w2v_t;
  u16 *zs, *q, *kcmp, *vcmp, *kslc, *vslcT, *kwin, *vwinT, *za, *hid_k, *hid_v, *kc, *vcT, *xbc;
  float *states, *gates, *dtv, *ssq, *ssq2, *rope, *peb, *cd;
  unsigned* counter;
};


DI float bf2f(u16 v) { return __uint_as_float(((unsigned)v) << 16); }
typedef __attribute__((ext_vector_type(2))) __bf16 bf16x2_t;
typedef __attribute__((ext_vector_type(2))) float f32x2;
DI unsigned pack2(float a, float b) { f32x2 v = {a, b}; bf16x2_t r = __builtin_convertvector(v, bf16x2_t); return __builtin_bit_cast(unsigned, r); }
DI float lo_f(unsigned v) { return __uint_as_float(v << 16); }
DI float hi_f(unsigned v) { return __uint_as_float(v & 0xffff0000u); }
DI float silu_f(float x) { return x * __builtin_amdgcn_rcpf(1.f + __expf(-x)); }
DI float sigmoid_f(float x) { return __builtin_amdgcn_rcpf(1.f + __expf(-x)); }
DI float softplus_f(float x) { return fmaxf(x, 0.f) + log1pf(__expf(-fabsf(x))); }
DI float gelu_tanh(float x) { float u = 0.7978845608028654f * (x + 0.044715f * x * x * x); return 0.5f * x * (1.f + tanhf(u)); }
DI u16 f2bf(float x) { return (u16)(pack2(x, 0.f) & 0xffffu); }
DI float exp2_f(float x) { return __builtin_amdgcn_exp2f(x); }
DI f32x4 mfma16(bf16x8 a, bf16x8 b, f32x4 c) { return __builtin_amdgcn_mfma_f32_16x16x32_bf16(a, b, c, 0, 0, 0); }
DI bf16x8 as_bf16x8(U4 v) { return __builtin_bit_cast(bf16x8, v); }
DI bf16x8 as_bf16x8(unsigned a, unsigned b, unsigned c, unsigned d) { u32x4 t = {a, b, c, d}; return __builtin_bit_cast(bf16x8, t); }
DI float max3_f(float a, float b, float c) { float r; asm("v_max3_f32 %0, %1, %2, %3" : "=v"(r) : "v"(a), "v"(b), "v"(c)); return r; }
DI float quad_max(float v) {
  unsigned u = __float_as_uint(v);
  auto a = __builtin_amdgcn_permlane16_swap(u, u, false, false);
  v = max3_f(__uint_as_float(a[0]), __uint_as_float(a[1]), __uint_as_float(a[1]));
  u = __float_as_uint(v);
  auto b = __builtin_amdgcn_permlane32_swap(u, u, false, false);
  return max3_f(__uint_as_float(b[0]), __uint_as_float(b[1]), __uint_as_float(b[1]));
}
DI float quad_sum(float v) {
  unsigned u = __float_as_uint(v);
  auto a = __builtin_amdgcn_permlane16_swap(u, u, false, false);
  v = __uint_as_float(a[0]) + __uint_as_float(a[1]);
  u = __float_as_uint(v);
  auto b = __builtin_amdgcn_permlane32_swap(u, u, false, false);
  return __uint_as_float(b[0]) + __uint_as_float(b[1]);
}
typedef __attribute__((ext_vector_type(4))) short s16x4;
DI bf16x8 tr_frag(const u16* a0, const u16* a1) {
  const s16x4 x = __builtin_amdgcn_ds_read_tr16_b64_v4i16((__attribute__((address_space(3))) s16x4*)a0);
  const s16x4 y = __builtin_amdgcn_ds_read_tr16_b64_v4i16((__attribute__((address_space(3))) s16x4*)a1);
  return __builtin_shufflevector(x, y, 0, 1, 2, 3, 4, 5, 6, 7);
}
DI int otid() { int t = threadIdx.x; asm volatile("" : "+v"(t)); return t; }
DI float wave_sum(float v) {
#pragma unroll
  for (int o = 32; o > 0; o >>= 1) v += __shfl_xor(v, o, 64);
  return v;
}
DI int srccol(int n) {
  if (n < 3072) return n;
  if (n < 5632) return n + 16;
  if (n < 6656) return n + 64;
  if (n < 6704) return n - 6656 + 5648;
  if (n < 6720) return n - 6704 + 3072;
  if (n < 6784) return -1;
  return n - 6784 + 6720;
}

DI void wt_tile(const float* src, int ld_src, int k0, int n0, u16* dst, int ld_dst, int mode, const float* kscale, float* tile) {
  const int tid = otid(), n4 = (tid & 15) * 4, kl0 = tid >> 4;
  const int n = n0 + n4;
  const int sc = (mode == 1) ? srccol(n) : n;
#pragma unroll
  for (int i = 0; i < 4; ++i) {
    const int kl = kl0 + 16 * i;
    f32x4 v = {0.f, 0.f, 0.f, 0.f};
    if (sc >= 0) v = __builtin_nontemporal_load((const f32x4*)(src + (size_t)(k0 + kl) * ld_src + sc));
    if (kscale) v *= kscale[k0 + kl];
    tile[kl * 65 + n4] = v[0]; tile[kl * 65 + n4 + 1] = v[1]; tile[kl * 65 + n4 + 2] = v[2]; tile[kl * 65 + n4 + 3] = v[3];
  }
  __syncthreads();
  const int nr = tid >> 2, kc = (tid & 3) * 16;
  unsigned w[8];
#pragma unroll
  for (int e = 0; e < 8; ++e) w[e] = pack2(tile[(kc + 2 * e) * 65 + nr], tile[(kc + 2 * e + 1) * 65 + nr]);
  U4* d = (U4*)(dst + (size_t)(n0 + nr) * ld_dst + k0 + kc);
  d[0] = U4{w[0], w[1], w[2], w[3]};
  d[1] = U4{w[4], w[5], w[6], w[7]};
  __syncthreads();
}

DI void phase0(const Params& p, unsigned char* smem) {
  const int tid = otid(), lane = tid & 63, wave = tid >> 6;
  float* tile = (float*)smem;
  const int NA = 4096, NB = 138 * 16, NC = 768, ND = 256, NE = 8, NF = 1024, NGI = 64;
  const int total = NA + NB + NC + ND + NE + NF + NGI;
  for (int it = blockIdx.x; it < total; it += gridDim.x) {
    int i = it;
    if (i < NA) {
      const int row = i * 4 + wave;
      const float4* xr = (const float4*)(p.x + (size_t)row * DM);
      float4 v[4]; float ss = 0.f;
#pragma unroll
      for (int k = 0; k < 4; ++k) { const f32x4 t4 = __builtin_nontemporal_load((const f32x4*)xr + lane + 64 * k); v[k] = make_float4(t4[0], t4[1], t4[2], t4[3]); ss += v[k].x * v[k].x + v[k].y * v[k].y + v[k].z * v[k].z + v[k].w * v[k].w; }
      ss = wave_sum(ss);
      const float r = rsqrtf(ss * (1.f / DM) + EPS);
#pragma unroll
      for (int k = 0; k < 4; ++k) {
        const float4 w4 = ((const float4*)p.norm_w)[lane + 64 * k];
        U2 o; o.x = pack2(v[k].x * r * w4.x, v[k].y * r * w4.y); o.y = pack2(v[k].z * r * w4.z, v[k].w * r * w4.w);
        *(U2*)(p.hbf + (size_t)row * LDH + (lane + 64 * k) * 4) = o;
      }
      continue;
    }
    i -= NA;
    if (i < NB) { wt_tile(p.w_in, IN_TOTAL, (i & 15) * 64, (i >> 4) * 64, p.wt, LDH, 1, nullptr, tile); continue; }
    i -= NB;
    if (i < NC) {
      const int which = i >> 8, t = i & 255;
      const float* src = which == 0 ? p.w_bs : (which == 1 ? p.w_ba : p.w_out);
      u16* dst = which == 0 ? p.wbs_t : (which == 1 ? p.wba_t : p.wout_t);
      wt_tile(src, DM, (t & 15) * 64, (t >> 4) * 64, dst, DM, 0, which == 0 ? p.ssm_norm_w : nullptr, tile);
      continue;
    }
    i -= NC;
    if (i < ND) {
      const int which = i >> 7, t = i & 127;
      wt_tile(which ? p.cv_w1 : p.ck_w1, 256, (t & 31) * 64, (t >> 5) * 64, which ? p.w1v_t : p.w1k_t, 2048, 0, nullptr, tile);
      continue;
    }
    i -= ND;
    if (i < NE) {
      const int which = i >> 2, t = i & 3;
      wt_tile(which ? p.cv_w2 : p.ck_w2, 64, t * 64, 0, which ? p.w2v_t : p.w2k_t, 256, 0, nullptr, tile);
      continue;
    }
    i -= NE;
    if (i < NF) {
      const int e = i * 256 + tid; const int t = e >> 5, d = e & 31;
      const float inv = 1.0f / powf(10000.0f, (float)d * (2.0f / 64.0f));
      const float ang = (float)t * inv;
      float s, c; sincosf(ang, &s, &c);
      ((float2*)p.rope)[e] = make_float2(c, s);
      continue;
    }
    i -= NF;
    {
      const int which = i >> 5, chunk = i & 31;
      const float* w1 = which ? p.cv_w1 : p.ck_w1; const float* pe = which ? p.cmp_pos_v : p.cmp_pos_k;
      float acc = 0.f;
#pragma unroll 8
      for (int k = chunk * 64; k < chunk * 64 + 64; ++k) acc += pe[k] * w1[k * 256 + tid];
      p.peb[i * 256 + tid] = acc;
    }
  }
}

DI void glds16(const void* g, void* l) {
  __builtin_amdgcn_global_load_lds((const __attribute__((address_space(1))) unsigned*)g, (__attribute__((address_space(3))) unsigned*)l, 16, 0, 0);
}
template <int N> DI void wait_vm() { asm volatile("s_waitcnt vmcnt(%0)" ::"n"(N) : "memory"); }
DI void raw_barrier() { asm volatile("s_waitcnt lgkmcnt(0)" ::: "memory"); __builtin_amdgcn_s_barrier(); }

template <int MT, int NT>
DI void gemm_core(const u16* A, int lda, const u16* Bt, int ldb, int K, f32x4 (&acc)[MT][NT], u16* sm) {
  constexpr int BM = MT * 32, BN = NT * 32;
  constexpr int AI = BM / 32, BI = BN / 32;
  constexpr int STAGE = (BM + BN) * 128;
  static_assert(2 * STAGE <= 65536, "ring does not fit");
  unsigned char* base = (unsigned char*)sm;
  const int tid = otid(), lane = tid & 63, wave = tid >> 6, wm = wave >> 1, wn = wave & 1;
  const int l15 = lane & 15, q = lane >> 4;
  const int lrow = lane >> 3;
  const int lc = (lane & 7) ^ (((wave & 1) * 4 + (lane >> 4)) & 7);
  const u16* Ag = A + (size_t)(wave * 8 + lrow) * lda + lc * 8;
  const u16* Bg = Bt + (size_t)(wave * 8 + lrow) * ldb + lc * 8;
  const int wofs = wave * 8 * 128;
  const int nkt = K >> 6;
  raw_barrier();
#pragma unroll
  for (int i = 0; i < AI; ++i) glds16(Ag + (size_t)(i * 32) * lda, base + i * 4096 + wofs);
#pragma unroll
  for (int i = 0; i < BI; ++i) glds16(Bg + (size_t)(i * 32) * ldb, base + BM * 128 + i * 4096 + wofs);
  const int sw = (l15 >> 1) & 7;
  const int arow = (wm * MT * 16 + l15) * 128, brow = BM * 128 + (wn * NT * 16 + l15) * 128;
  int cb = 0;
  for (int kt = 0; kt < nkt; ++kt) {
    wait_vm<0>();
    raw_barrier();
    if (kt + 1 < nkt) {
      unsigned char* sb = base + (cb ^ 1) * STAGE;
      const int k0 = (kt + 1) * 64;
#pragma unroll
      for (int i = 0; i < AI; ++i) glds16(Ag + (size_t)(i * 32) * lda + k0, sb + i * 4096 + wofs);
#pragma unroll
      for (int i = 0; i < BI; ++i) glds16(Bg + (size_t)(i * 32) * ldb + k0, sb + BM * 128 + i * 4096 + wofs);
    }
    const unsigned char* cs = base + cb * STAGE;
#pragma unroll
    for (int ks = 0; ks < 2; ++ks) {
      const int pc = ((ks * 4 + q) ^ sw) * 16;
      bf16x8 af[MT], bfr[NT];
#pragma unroll
      for (int mt = 0; mt < MT; ++mt) af[mt] = *(const bf16x8*)(cs + arow + mt * 2048 + pc);
#pragma unroll
      for (int nt = 0; nt < NT; ++nt) bfr[nt] = *(const bf16x8*)(cs + brow + nt * 2048 + pc);
#pragma unroll
      for (int mt = 0; mt < MT; ++mt)
#pragma unroll
        for (int nt = 0; nt < NT; ++nt) acc[mt][nt] = mfma16(af[mt], bfr[nt], acc[mt][nt]);
    }
    cb ^= 1;
  }
}

template <int MT, int NT>
DI void zero_acc(f32x4 (&acc)[MT][NT]) {
#pragma unroll
  for (int a = 0; a < MT; ++a)
#pragma unroll
    for (int b = 0; b < NT; ++b) acc[a][b] = f32x4{0.f, 0.f, 0.f, 0.f};
}

template <int PM = 8, int PN = 8, class F>
DI void patch_walk(int MT_, int NT_, F f) {
  static_assert(PM * PN == 64, "a patch is 64 tiles");
  const int xcd = blockIdx.x & 7, local = blockIdx.x >> 3, L = gridDim.x >> 3;
  const int npc = (NT_ + PN - 1) / PN, npatch = ((MT_ + PM - 1) / PM) * npc;
  for (int s = local;; s += L) {
    const int P = (s >> 6) * 8 + xcd;
    if (P >= npatch) break;
    const int w = s & 63;
    const int mt = (P / npc) * PM + (w / PN), nt = (P % npc) * PN + (w % PN);
    if (mt < MT_ && nt < NT_) f(mt, nt);
  }
}

DI void gemm1_tile(const Params& p, int mt_i, int nt_i, unsigned char* smem) {
  const int m0 = mt_i * 128, n0 = nt_i * 128;
  f32x4 acc[4][4]; zero_acc(acc);
  gemm_core<4, 4>(p.hbf + (size_t)m0 * LDH, LDH, p.wt + (size_t)n0 * LDH, LDH, DM, acc, (u16*)smem);
  const int tid = otid(), lane = tid & 63, wave = tid >> 6, wm = wave >> 1, wn = wave & 1, l15 = lane & 15, q = lane >> 4;
  const int col0 = n0 + wn * 64, rbase = m0 + wm * 64;
#ifdef PROBE_EPIX2
#pragma unroll 1
  for (int rep = 0; rep < 2; ++rep)
#endif
  if (col0 < 1024) {
#pragma unroll
    for (int mt = 0; mt < 4; ++mt)
#pragma unroll
      for (int nt = 0; nt < 4; ++nt)
#pragma unroll
        for (int j = 0; j < 4; ++j) __builtin_nontemporal_store(f2bf(silu_f(acc[mt][nt][j])), &p.zs[(size_t)(rbase + mt * 16 + q * 4 + j) * 1024 + col0 + nt * 16 + l15]);
  } else if (col0 < 3072) {
    u16* halo = (u16*)p.states;
#pragma unroll
    for (int mt = 0; mt < 4; ++mt)
#pragma unroll
      for (int nt = 0; nt < 4; ++nt)
#pragma unroll
        for (int j = 0; j < 4; ++j) {
          const u16 v = f2bf(acc[mt][nt][j]);
          __builtin_nontemporal_store(v, &p.xbc[(size_t)(rbase + mt * 16 + q * 4 + j) * 2048 + (col0 - 1024) + nt * 16 + l15]);
          if (mt == 3 && j >= 1 && q == 3) halo[(size_t)((rbase >> 6) * 3 + (j - 1)) * 2048 + (col0 - 1024) + nt * 16 + l15] = v;
        }
  } else if (col0 < 4096) {
    const int hc = col0 - 3072;
#pragma unroll
    for (int mt = 0; mt < 4; ++mt)
#pragma unroll
      for (int j = 0; j < 4; ++j) {
        const int row = rbase + mt * 16 + q * 4 + j; const int t = row & (SEQ - 1);
#pragma unroll
        for (int nt = 0; nt < 2; ++nt) {
          const int d = nt * 16 + l15;
          const float2 cs = ((const float2*)p.rope)[t * 32 + d];
          const float u1 = acc[mt][nt][j], u2 = acc[mt][nt + 2][j];
          p.q[(size_t)row * 1024 + hc + d] = f2bf((u1 * cs.x - u2 * cs.y) * 0.18033688011112042f);
          p.q[(size_t)row * 1024 + hc + d + 32] = f2bf((u2 * cs.x + u1 * cs.y) * 0.18033688011112042f);
        }
      }
  } else if (col0 < 5632) {
    const int kc0 = col0 - 4096; const int s6 = kc0 >> 8; const int g = (kc0 & 255) >> 6;
    const int b = rbase >> 13;
    if (s6 == 3 || s6 == 5) {
      u16* dst = (s6 == 3 ? p.vslcT : p.vwinT) + (size_t)(b * 4 + g) * 64 * SEQ;
#pragma unroll
      for (int mt = 0; mt < 4; ++mt)
#pragma unroll
        for (int nt = 0; nt < 4; ++nt) {
          const int t0 = (rbase + mt * 16 + q * 4) & (SEQ - 1); const int d = nt * 16 + l15;
          U2 o; o.x = pack2(acc[mt][nt][0], acc[mt][nt][1]); o.y = pack2(acc[mt][nt][2], acc[mt][nt][3]);
          *(U2*)(dst + (size_t)d * SEQ + t0) = o;
        }
    } else if (s6 == 1) {
      u16* dst = p.vcmp + (size_t)(b * 4 + g) * SEQ * 64;
#pragma unroll
      for (int mt = 0; mt < 4; ++mt)
#pragma unroll
        for (int nt = 0; nt < 4; ++nt)
#pragma unroll
          for (int j = 0; j < 4; ++j) dst[(size_t)((rbase + mt * 16 + q * 4 + j) & (SEQ - 1)) * 64 + nt * 16 + l15] = f2bf(acc[mt][nt][j]);
    } else {
      u16* dst = (s6 == 0 ? p.kcmp : (s6 == 2 ? p.kslc : p.kwin)) + (size_t)(b * 4 + g) * SEQ * 64;
#pragma unroll
      for (int mt = 0; mt < 4; ++mt)
#pragma unroll
        for (int j = 0; j < 4; ++j) {
          const int t = (rbase + mt * 16 + q * 4 + j) & (SEQ - 1);
#pragma unroll
          for (int nt = 0; nt < 2; ++nt) {
            const int d = nt * 16 + l15;
            const float2 cs = ((const float2*)p.rope)[t * 32 + d];
            const float u1 = acc[mt][nt][j], u2 = acc[mt][nt + 2][j];
            dst[(size_t)t * 64 + d] = f2bf(u1 * cs.x - u2 * cs.y);
            dst[(size_t)t * 64 + d + 32] = f2bf(u2 * cs.x + u1 * cs.y);
          }
        }
    }
  } else if (col0 < 6656) {
#pragma unroll
    for (int mt = 0; mt < 4; ++mt)
#pragma unroll
      for (int nt = 0; nt < 4; ++nt)
#pragma unroll
        for (int j = 0; j < 4; ++j) __builtin_nontemporal_store(f2bf(silu_f(acc[mt][nt][j])), &p.za[(size_t)(rbase + mt * 16 + q * 4 + j) * 1024 + (col0 - 5632) + nt * 16 + l15]);
  } else if (col0 < 6720) {
    const float dtb = p.dt_bias[l15];
#pragma unroll
    for (int mt = 0; mt < 4; ++mt)
#pragma unroll
      for (int j = 0; j < 4; ++j) {
        const int row = rbase + mt * 16 + q * 4 + j;
#pragma unroll
        for (int nt = 0; nt < 3; ++nt) p.gates[(size_t)row * 48 + nt * 16 + l15] = sigmoid_f(acc[mt][nt][j]);
        p.dtv[(size_t)row * 16 + l15] = softplus_f(acc[mt][3][j] + dtb);
      }
  }
}

DI void gemm1_mini_tile(const Params& p, int mt_i, unsigned char* smem) {
  const int m0 = mt_i * 64;
  f32x4 acc[2][2]; zero_acc(acc);
  gemm_core<2, 2>(p.hbf + (size_t)m0 * LDH, LDH, p.wt + (size_t)6656 * LDH, LDH, DM, acc, (u16*)smem);
  const int tid = otid(), lane = tid & 63, wave = tid >> 6, wm = wave >> 1, wn = wave & 1, l15 = lane & 15, q = lane >> 4;
  const float dtb = p.dt_bias[l15];
#pragma unroll
  for (int mt = 0; mt < 2; ++mt)
#pragma unroll
    for (int j = 0; j < 4; ++j) {
      const int row = m0 + wm * 32 + mt * 16 + q * 4 + j;
      if (wn == 0) {
        p.gates[(size_t)row * 48 + l15] = sigmoid_f(acc[mt][0][j]);
        p.gates[(size_t)row * 48 + 16 + l15] = sigmoid_f(acc[mt][1][j]);
      } else {
        p.gates[(size_t)row * 48 + 32 + l15] = sigmoid_f(acc[mt][0][j]);
        p.dtv[(size_t)row * 16 + l15] = softplus_f(acc[mt][1][j] + dtb);
      }
    }
}

DI void unpack8(const U4& v, float (&f)[8]) {
  f[0] = lo_f(v.x); f[1] = hi_f(v.x); f[2] = lo_f(v.y); f[3] = hi_f(v.y); f[4] = lo_f(v.z); f[5] = hi_f(v.z); f[6] = lo_f(v.w); f[7] = hi_f(v.w);
}
template <int NCH, int RPS>
DI void conv_fetch(const Params& p, U4 (&u)[RPS + 3], int grow0, int t0, int ch0) {
  constexpr int NCG = NCH / 8;
  const int tid = otid(); const int cgi = tid % NCG, seg = tid / NCG;
  int ch = ch0 + cgi * 8;
  asm volatile("" : "+v"(ch));
  const u16* src = p.xbc + (size_t)grow0 * 2048 + ch;
  const int r0 = seg * RPS;
#pragma unroll
  for (int k = 0; k < RPS; ++k) u[k + 3] = *(const U4*)(src + (r0 + k) * 2048);
}
template <int NCH, int RPS>
DI void conv_apply(const Params& p, const U4 (&u)[RPS + 3], u16* dst, int dstride, int ch0, const float* rscale) {
  constexpr int NCG = NCH / 8;
  const int tid = otid(); const int cgi = tid % NCG, seg = tid / NCG;
  const int r0 = seg * RPS;
#pragma unroll
  for (int k = 0; k < RPS; ++k) {
    U4 v = u[k + 3];
    if (rscale) {
      float f0[8]; unpack8(v, f0);
      const float sc = rscale[r0 + k];
      v = U4{pack2(f0[0] * sc, f0[1] * sc), pack2(f0[2] * sc, f0[3] * sc), pack2(f0[4] * sc, f0[5] * sc), pack2(f0[6] * sc, f0[7] * sc)};
    }
    *(U4*)(dst + (r0 + k) * dstride + cgi * 8) = v;
  }
}
template <int NCH, int RPS>
DI void conv_load(const Params& p, u16* dst, int dstride, int grow0, int t0, int ch0, const float* rscale) {
  U4 u[RPS + 3];
  conv_fetch<NCH, RPS>(p, u, grow0, t0, ch0);
  conv_apply<NCH, RPS>(p, u, dst, dstride, ch0, rscale);
}

DI void preconv_item(const Params& p, int item) {
  const int tid = otid();
  const int slab = item >> 1, chalf = item & 1;
  const int cgi = tid & 127, rh = tid >> 7;
  const int ch = chalf * 1024 + cgi * 8;
  const int r0 = slab * 64 + rh * 32;
  float w0[8], w1[8], w2[8], w3[8], bs[8];
#pragma unroll
  for (int h = 0; h < 2; ++h) {
    const float4 a0 = *(const float4*)(p.conv_w + 0 * 2048 + ch + h * 4), a1 = *(const float4*)(p.conv_w + 1 * 2048 + ch + h * 4);
    const float4 a2 = *(const float4*)(p.conv_w + 2 * 2048 + ch + h * 4), a3 = *(const float4*)(p.conv_w + 3 * 2048 + ch + h * 4);
    const float4 bb = *(const float4*)(p.conv_b + ch + h * 4);
    w0[h * 4 + 0] = a0.x; w0[h * 4 + 1] = a0.y; w0[h * 4 + 2] = a0.z; w0[h * 4 + 3] = a0.w;
    w1[h * 4 + 0] = a1.x; w1[h * 4 + 1] = a1.y; w1[h * 4 + 2] = a1.z; w1[h * 4 + 3] = a1.w;
    w2[h * 4 + 0] = a2.x; w2[h * 4 + 1] = a2.y; w2[h * 4 + 2] = a2.z; w2[h * 4 + 3] = a2.w;
    w3[h * 4 + 0] = a3.x; w3[h * 4 + 1] = a3.y; w3[h * 4 + 2] = a3.z; w3[h * 4 + 3] = a3.w;
    bs[h * 4 + 0] = bb.x; bs[h * 4 + 1] = bb.y; bs[h * 4 + 2] = bb.z; bs[h * 4 + 3] = bb.w;
  }
  u16* xb = p.xbc + (size_t)r0 * 2048 + ch;
  const U4 z4 = U4{0u, 0u, 0u, 0u};
  U4 um3, um2, um1;
  if (rh == 1) {
    um3 = *(const U4*)(xb - 3 * 2048); um2 = *(const U4*)(xb - 2 * 2048); um1 = *(const U4*)(xb - 1 * 2048);
  } else if ((r0 & (SEQ - 1)) == 0) {
    um3 = z4; um2 = z4; um1 = z4;
  } else {
    const u16* hp = (const u16*)p.states + (size_t)((slab - 1) * 3) * 2048 + ch;
    um3 = *(const U4*)hp; um2 = *(const U4*)(hp + 2048); um1 = *(const U4*)(hp + 4096);
  }
  __syncthreads();
#pragma unroll 1
  for (int rb8 = 0; rb8 < 32; rb8 += 8) {
    U4 u[8];
#pragma unroll
    for (int k = 0; k < 8; ++k) u[k] = *(const U4*)(xb + (rb8 + k) * 2048);
#pragma unroll
    for (int k = 0; k < 8; ++k) {
      float f3[8], f2[8], f1[8], f0[8], o[8];
      unpack8(um3, f3); unpack8(um2, f2); unpack8(um1, f1); unpack8(u[k], f0);
#pragma unroll
      for (int e = 0; e < 8; ++e) o[e] = silu_f(bs[e] + w0[e] * f3[e] + w1[e] * f2[e] + w2[e] * f1[e] + w3[e] * f0[e]);
      *(U4*)(xb + (rb8 + k) * 2048) = U4{pack2(o[0], o[1]), pack2(o[2], o[3]), pack2(o[4], o[5]), pack2(o[6], o[7])};
      um3 = um2; um2 = um1; um1 = u[k];
    }
  }
}

DI float block_scan256(float v, float* tmp  ) {
  const int lane = threadIdx.x & 63, wave = threadIdx.x >> 6;
#pragma unroll
  for (int o = 1; o < 64; o <<= 1) { const float t = __shfl_up(v, o, 64); if (lane >= o) v += t; }
  if (lane == 63) tmp[wave] = v;
  __syncthreads();
  float add = 0.f;
  if (wave > 0) add += tmp[0];
  if (wave > 1) add += tmp[1];
  if (wave > 2) add += tmp[2];
  return v + add;
}
DI void scan256(float* a) {
  const int tid = otid();
  for (int off = 1; off < 256; off <<= 1) {
    const float t = (tid >= off) ? a[tid - off] : 0.f;
    __syncthreads();
    a[tid] += t;
    __syncthreads();
  }
}

DI void ssd_states_item(const Params& p, int item, unsigned char* smem) {
  const int tid = otid(), lane = tid & 63, wave = tid >> 6, l15 = lane & 15, q = lane >> 4;
  const int b = item >> 9, c = (item >> 4) & 31, h = item & 15, g = h >> 2;
  float* acs = (float*)smem; float* wsc = acs + 256;
  u16* Xs = (u16*)(smem + 2048); u16* Bs = Xs + 128 * 72;
  const int rb = b * SEQ + c * 256;
  const float A_h = -expf(p.a_log[h]);
  const float dtl = p.dtv[(size_t)(rb + tid) * 16 + h];
  __syncthreads();
  acs[tid] = block_scan256(dtl * A_h, (float*)(smem + 65536 + 16));
  __syncthreads();
  const float tot = acs[255];
  wsc[tid] = __expf(tot - acs[tid]) * dtl;
  if (tid == 255) p.cd[(b * 32 + c) * 16 + h] = __expf(tot);
  f32x4 acc[4][2]; zero_acc(acc);
  for (int half = 0; half < 2; ++half) {
    __syncthreads();
    {
      U4 ux[7], ub[11];
      conv_fetch<64, 4>(p, ux, rb + half * 128, c * 256 + half * 128, h * 64);
      conv_fetch<128, 8>(p, ub, rb + half * 128, c * 256 + half * 128, 1024 + g * 128);
      conv_apply<64, 4>(p, ux, Xs, 72, h * 64, wsc + half * 128);
      conv_apply<128, 8>(p, ub, Bs, 136, 1024 + g * 128, nullptr);
    }
    __syncthreads();
#pragma unroll
    for (int ks = 0; ks < 4; ++ks) {
      bf16x8 af[4], bfr[2];
#pragma unroll
      for (int pt = 0; pt < 4; ++pt) {
        const u16* s = Xs + (ks * 32 + q * 8 + (l15 >> 2)) * 72 + pt * 16 + (l15 & 3) * 4;
        af[pt] = tr_frag(s, s + 4 * 72);
      }
#pragma unroll
      for (int nt = 0; nt < 2; ++nt) {
        const u16* s = Bs + (ks * 32 + q * 8 + (l15 >> 2)) * 136 + (wave * 2 + nt) * 16 + (l15 & 3) * 4;
        bfr[nt] = tr_frag(s, s + 4 * 136);
      }
#pragma unroll
      for (int pt = 0; pt < 4; ++pt)
#pragma unroll
        for (int nt = 0; nt < 2; ++nt) acc[pt][nt] = mfma16(af[pt], bfr[nt], acc[pt][nt]);
    }
  }
  float* st = p.states + (size_t)item * 8192;
#pragma unroll
  for (int pt = 0; pt < 4; ++pt)
#pragma unroll
    for (int nt = 0; nt < 2; ++nt)
#pragma unroll
      for (int j = 0; j < 4; ++j) st[(pt * 16 + q * 4 + j) * 128 + (wave * 2 + nt) * 16 + l15] = acc[pt][nt][j];
}

DI void cmp_a_tile(const Params& p, int tile, unsigned char* smem) {
  const int which = tile >> 7, r = tile & 127; const int bg = r >> 4, mt_i = (r >> 1) & 7, nt_i = r & 1;
  const u16* A = (which ? p.vcmp : p.kcmp) + (size_t)bg * SEQ * 64 + (size_t)(mt_i * 64) * 1024;
  const u16* Bt = (which ? p.w1v_t : p.w1k_t) + (size_t)(nt_i * 128) * 2048;
  f32x4 acc[2][4]; zero_acc(acc);
  gemm_core<2, 4>(A, 1024, Bt, 2048, 2048, acc, (u16*)smem);
  const int tid = otid(), lane = tid & 63, wave = tid >> 6, wm = wave >> 1, wn = wave & 1, l15 = lane & 15, q = lane >> 4;
  u16* hid = which ? p.hid_v : p.hid_k;
#pragma unroll
  for (int nt = 0; nt < 4; ++nt) {
    const int col = nt_i * 128 + wn * 64 + nt * 16 + l15;
    float bias = (which ? p.cv_b1 : p.ck_b1)[col];
    for (int c = 0; c < 32; ++c) bias += p.peb[(which * 32 + c) * 256 + col];
#pragma unroll
    for (int mt = 0; mt < 2; ++mt)
#pragma unroll
      for (int j = 0; j < 4; ++j) {
        const int row = bg * 512 + mt_i * 64 + wm * 32 + mt * 16 + q * 4 + j;
        hid[(size_t)row * 256 + col] = f2bf(gelu_tanh(acc[mt][nt][j] + bias));
      }
  }
}

DI void scan_item(const Params& p, int item) {
  const int e4 = item * 256 + threadIdx.x;
  const int b = e4 >> 15, h = (e4 >> 11) & 15, r = e4 & 2047;
  float4* st = (float4*)p.states;
  float4 carry = make_float4(0.f, 0.f, 0.f, 0.f);
#pragma unroll 1
  for (int c0 = 0; c0 < 32; c0 += 16) {
    float4 sv[16]; float dv[16];
#pragma unroll
    for (int k = 0; k < 16; ++k) { sv[k] = st[(size_t)((b * 32 + c0 + k) * 16 + h) * 2048 + r]; dv[k] = p.cd[(b * 32 + c0 + k) * 16 + h]; }
#pragma unroll
    for (int k = 0; k < 16; ++k) {
      st[(size_t)((b * 32 + c0 + k) * 16 + h) * 2048 + r] = carry;
      carry.x = dv[k] * carry.x + sv[k].x; carry.y = dv[k] * carry.y + sv[k].y; carry.z = dv[k] * carry.z + sv[k].z; carry.w = dv[k] * carry.w + sv[k].w;
    }
  }
}

DI void cmp_b_tile(const Params& p, int tile, unsigned char* smem) {
  const int which = tile >> 5, mt_i = tile & 31;
  f32x4 acc[4][2]; zero_acc(acc);
  gemm_core<4, 2>((which ? p.hid_v : p.hid_k) + (size_t)(mt_i * 128) * 256, 256, which ? p.w2v_t : p.w2k_t, 256, 256, acc, (u16*)smem);
  const int tid = otid(), lane = tid & 63, wave = tid >> 6, wm = wave >> 1, wn = wave & 1, l15 = lane & 15, q = lane >> 4;
#pragma unroll
  for (int mt = 0; mt < 4; ++mt)
#pragma unroll
    for (int nt = 0; nt < 2; ++nt) {
      const int row0 = mt_i * 128 + wm * 64 + mt * 16 + q * 4; const int col = wn * 32 + nt * 16 + l15;
      const int bg = row0 >> 9, i0 = row0 & 511;
      if (which == 0) {
#pragma unroll
        for (int j = 0; j < 4; ++j) p.kc[(size_t)(row0 + j) * 64 + col] = (i0 + j == 511) ? (u16)0 : f2bf(acc[mt][nt][j]);
      } else {
        U2 o; o.x = pack2(acc[mt][nt][0], acc[mt][nt][1]); o.y = pack2(acc[mt][nt][2], (i0 + 3 == 511) ? 0.f : acc[mt][nt][3]);
        *(U2*)(p.vcT + (size_t)(bg * 64 + col) * 512 + i0) = o;
      }
    }
}

DI void ssd_y_item(const Params& p, int item, unsigned char* smem, int rep) {
  const int tid = otid(), lane = tid & 63, wave = tid >> 6, l15 = lane & 15, q = lane >> 4;
  const int b = item >> 9, c = (item >> 4) & 31, h = item & 15, g = h >> 2;
  float* acs = (float*)smem; float* dts = acs + 256;
  u16* R1 = (u16*)(smem + 2048);
  u16* Ps = (u16*)(smem + 2048 + 34816);
  u16* Bts = R1; u16* Xts = R1 + 64 * 136;
  const int rb = b * SEQ + c * 256;
  const float A_h = -expf(p.a_log[h]);
  const float Dh = p.d_skip[h];
  const float dtl = p.dtv[(size_t)(rb + tid) * 16 + h];
  __syncthreads();
  acs[tid] = block_scan256(dtl * A_h, (float*)(smem + 65536 + 16)); dts[tid] = dtl;
  __syncthreads();
  {
    const float4* st = (const float4*)(p.states + (size_t)item * 8192);
#pragma unroll
    for (int i = 0; i < 8; ++i) {
      const int idx = tid + i * 256; const float4 v = st[idx];
      U2 o; o.x = pack2(v.x, v.y); o.y = pack2(v.z, v.w);
      *(U2*)(Ps + (idx >> 5) * 136 + (idx & 31) * 4) = o;
    }
  }
  for (int lh = 0; lh < 2; ++lh) {
    __syncthreads();
    conv_load<128, 8>(p, R1, 136, rb + lh * 128, c * 256 + lh * 128, 1536 + g * 128, nullptr);
    __syncthreads();
    bf16x8 Cf[2][4]; int lrow[2]; float acl[2];
#pragma unroll
    for (int nt = 0; nt < 2; ++nt) {
      lrow[nt] = lh * 128 + wave * 32 + nt * 16 + l15; acl[nt] = acs[lrow[nt]];
#pragma unroll
      for (int ks = 0; ks < 4; ++ks) Cf[nt][ks] = *(const bf16x8*)(R1 + (wave * 32 + nt * 16 + l15) * 136 + ks * 32 + q * 8);
    }
    f32x4 O[4][2]; zero_acc(O);
#pragma unroll
    for (int dt = 0; dt < 4; ++dt)
#pragma unroll
      for (int ks = 0; ks < 4; ++ks) {
        const bf16x8 a = *(const bf16x8*)(Ps + (dt * 16 + l15) * 136 + ks * 32 + q * 8);
#pragma unroll
        for (int nt = 0; nt < 2; ++nt) O[dt][nt] = mfma16(a, Cf[nt][ks], O[dt][nt]);
      }
#pragma unroll
    for (int nt = 0; nt < 2; ++nt) {
      const float e = __expf(acl[nt]);
#pragma unroll
      for (int dt = 0; dt < 4; ++dt) O[dt][nt] *= e;
    }
    const int nsb = lh * 2 + 2;
    for (int sb = 0; sb < nsb; ++sb) {
      __syncthreads();
      {
        U4 ub[7], ux[5];
        conv_fetch<128, 4>(p, ub, rb + sb * 64, c * 256 + sb * 64, 1024 + g * 128);
        conv_fetch<64, 2>(p, ux, rb + sb * 64, c * 256 + sb * 64, h * 64);
        conv_apply<128, 4>(p, ub, Bts, 136, 1024 + g * 128, nullptr);
        conv_apply<64, 2>(p, ux, Xts, 72, h * 64, nullptr);
      }
      __syncthreads();
      if (sb * 64 <= lh * 128 + wave * 32 + 31) {
#pragma unroll 1
        for (int kp = 0; kp < 2; ++kp) {
          f32x4 S[2][2]; zero_acc(S);
#pragma unroll
          for (int k2 = 0; k2 < 2; ++k2)
#pragma unroll
            for (int ks = 0; ks < 4; ++ks) {
              const bf16x8 a = *(const bf16x8*)(Bts + (kp * 32 + k2 * 16 + l15) * 136 + ks * 32 + q * 8);
#pragma unroll
              for (int nt = 0; nt < 2; ++nt) S[k2][nt] = mfma16(a, Cf[nt][ks], S[k2][nt]);
            }
#pragma unroll
          for (int k2 = 0; k2 < 2; ++k2) {
            const int s0 = sb * 64 + kp * 32 + k2 * 16 + q * 4;
            const float4 as4 = *(const float4*)(acs + s0); const float4 dt4 = *(const float4*)(dts + s0);
            const float asv[4] = {as4.x, as4.y, as4.z, as4.w}; const float dtv4[4] = {dt4.x, dt4.y, dt4.z, dt4.w};
#pragma unroll
            for (int nt = 0; nt < 2; ++nt)
#pragma unroll
              for (int j = 0; j < 4; ++j) {
                const int sidx = s0 + j;
                float v = (sidx <= lrow[nt]) ? S[k2][nt][j] * __expf(acl[nt] - asv[j]) * dtv4[j] : 0.f;
                if (sidx == lrow[nt]) v += Dh;
                S[k2][nt][j] = v;
              }
          }
          bf16x8 P[2];
#pragma unroll
          for (int nt = 0; nt < 2; ++nt)
            P[nt] = as_bf16x8(pack2(S[0][nt][0], S[0][nt][1]), pack2(S[0][nt][2], S[0][nt][3]), pack2(S[1][nt][0], S[1][nt][1]), pack2(S[1][nt][2], S[1][nt][3]));
#pragma unroll
          for (int dt = 0; dt < 4; ++dt) {
            const u16* sx = Xts + (kp * 32 + q * 4 + (l15 >> 2)) * 72 + dt * 16 + (l15 & 3) * 4;
            const bf16x8 a = tr_frag(sx, sx + 16 * 72);
#pragma unroll
            for (int nt = 0; nt < 2; ++nt) O[dt][nt] = mfma16(a, P[nt], O[dt][nt]);
          }
        }
      }
    }
#pragma unroll
    for (int nt = 0; nt < 2; ++nt) {
      const size_t rowoff = (size_t)(rb + lrow[nt]) * 1024 + h * 64;
      float ss = 0.f;
#pragma unroll
      for (int dt = 0; dt < 4; ++dt) {
        u16* zp = p.zs + rowoff + dt * 16 + q * 4;
        const U2 zv = *(const U2*)zp;
        const float v0 = O[dt][nt][0] * lo_f(zv.x), v1 = O[dt][nt][1] * hi_f(zv.x), v2 = O[dt][nt][2] * lo_f(zv.y), v3 = O[dt][nt][3] * hi_f(zv.y);
        ss += v0 * v0 + v1 * v1 + v2 * v2 + v3 * v3;
        U2 o; o.x = pack2(v0, v1); o.y = pack2(v2, v3);
        if (rep) *(U2*)zp = o;
      }
      ss += __shfl_xor(ss, 16, 64); ss += __shfl_xor(ss, 32, 64);
      if (q == 0 && rep) p.ssq[(size_t)(rb + lrow[nt]) * 16 + h] = ss;
    }
  }
}

template <int MODE>
DI void attn_pass(unsigned char* smem, const u16* Kg, const u16* VTg, int ldv, int jb0, int jb1, u64 act0, u64 act1,
                  const bf16x8 (&Qf)[4][2], float (&m)[4], float (&ls)[4], f32x4 (&O)[4][4],
                  const int (&lo)[4], const int (&hi)[4], const u64* selrow  ,
                  const float (&invL)[4], float* imp_row  ) {
  u16* Ks = (u16*)smem; u16* Vs = Ks + 64 * 72;
  const int tid = otid(), lane = tid & 63, l15 = lane & 15, q = lane >> 4;
  U4 rk[2], rv[2];
  int jb = jb0;
  while (jb <= jb1 && !(((jb < 64 ? (act0 >> jb) : (act1 >> (jb - 64))) & 1ull))) ++jb;
  if (jb > jb1) return;
#pragma unroll
  for (int i = 0; i < 2; ++i) {
    const int ci = tid + i * 256; const int row = ci >> 3, cc = ci & 7;
    rk[i] = *(const U4*)(Kg + (size_t)(jb * 64 + row) * 64 + cc * 8);
    if (MODE != 1) rv[i] = *(const U4*)(VTg + (size_t)row * ldv + jb * 64 + cc * 8);
  }
  float carry[4] = {0.f, 0.f, 0.f, 0.f};
  while (jb <= jb1) {
    __syncthreads();
#pragma unroll
    for (int i = 0; i < 2; ++i) {
      const int ci = tid + i * 256; const int row = ci >> 3, cc = ci & 7;
      *(U4*)(Ks + row * 72 + cc * 8) = rk[i];
      if (MODE != 1) *(U4*)(Vs + row * 72 + cc * 8) = rv[i];
    }
    __syncthreads();
    int nj = jb + 1;
    while (nj <= jb1 && !(((nj < 64 ? (act0 >> nj) : (act1 >> (nj - 64))) & 1ull))) ++nj;
    if (nj <= jb1) {
#pragma unroll
      for (int i = 0; i < 2; ++i) {
        const int ci = tid + i * 256; const int row = ci >> 3, cc = ci & 7;
        rk[i] = *(const U4*)(Kg + (size_t)(nj * 64 + row) * 64 + cc * 8);
        if (MODE != 1) rv[i] = *(const U4*)(VTg + (size_t)row * ldv + nj * 64 + cc * 8);
      }
    }
    bool rowok[4]; unsigned need = 0u; bool allin = true;
#pragma unroll
    for (int nt = 0; nt < 4; ++nt) {
      rowok[nt] = selrow ? (((selrow[nt * 8 + (jb >> 6)] >> (jb & 63)) & 1ull) != 0) : true;
      if (__ballot(rowok[nt]) != 0ull) need |= 1u << nt;
      allin = allin && (lo[nt] <= jb * 64) && (jb * 64 + 63 <= hi[nt]);
    }
    const bool interior = (__ballot(!allin) == 0ull);
    if (need != 0u) {
#pragma unroll 1
    for (int half = 0; half < 2; ++half) {
      const int kbase = jb * 64 + half * 32;
      bf16x8 ka[2][2], va[4];
#pragma unroll
      for (int kt2 = 0; kt2 < 2; ++kt2) {
        const u16* kr = Ks + (half * 32 + kt2 * 16 + l15) * 72 + q * 8;
        ka[kt2][0] = *(const bf16x8*)kr; ka[kt2][1] = *(const bf16x8*)(kr + 32);
      }
      if (MODE != 1) {
#pragma unroll
        for (int dt = 0; dt < 4; ++dt) {
          const u16* vr = Vs + (dt * 16 + l15) * 72 + half * 32 + q * 4;
          const U2 v0 = *(const U2*)vr; const U2 v1 = *(const U2*)(vr + 16);
          va[dt] = as_bf16x8(v0.x, v0.y, v1.x, v1.y);
        }
      }
#pragma unroll
      for (int nt = 0; nt < 4; ++nt) {
        if (need & (1u << nt)) {
          f32x4 S[2];
#pragma unroll
          for (int kt2 = 0; kt2 < 2; ++kt2) {
            S[kt2] = mfma16(ka[kt2][0], Qf[nt][0], f32x4{0.f, 0.f, 0.f, 0.f});
            S[kt2] = mfma16(ka[kt2][1], Qf[nt][1], S[kt2]);
          }
          if (!interior) {
#pragma unroll
            for (int kt2 = 0; kt2 < 2; ++kt2)
#pragma unroll
              for (int j = 0; j < 4; ++j) {
                const int kp = kbase + kt2 * 16 + q * 4 + j;
                S[kt2][j] = (kp >= lo[nt] && kp <= hi[nt]) ? S[kt2][j] : -__builtin_inff();
              }
          }
          if (MODE != 2) {
            float ml;
            {
              const float r1 = max3_f(S[0][0], S[0][1], S[0][2]), r2 = max3_f(S[0][3], S[1][0], S[1][1]), r3 = max3_f(S[1][2], S[1][3], S[1][3]);
              ml = max3_f(r1, r2, r3);
            }
            ml = rowok[nt] ? ml : -__builtin_inff();
            if (__ballot(ml > m[nt] + 8.f) != 0ull) {
              const float mx = quad_max(max3_f(ml, m[nt], m[nt]));
              const float alpha = exp2_f(m[nt] - mx);
              m[nt] = mx;
              ls[nt] *= alpha;
              if (MODE == 0) {
#pragma unroll
                for (int dt = 0; dt < 4; ++dt) O[dt][nt] *= alpha;
              }
            }
            const float neg = rowok[nt] ? m[nt] : __builtin_inff();
#pragma unroll
            for (int kt2 = 0; kt2 < 2; ++kt2)
#pragma unroll
              for (int j = 0; j < 4; ++j) S[kt2][j] = exp2_f(S[kt2][j] - neg);
            ls[nt] += ((S[0][0] + S[0][1]) + (S[0][2] + S[0][3])) + ((S[1][0] + S[1][1]) + (S[1][2] + S[1][3]));
          } else {
            float own = 0.f;
#pragma unroll
            for (int kt2 = 0; kt2 < 2; ++kt2)
#pragma unroll
              for (int j = 0; j < 4; ++j) S[kt2][j] = exp2_f(S[kt2][j] - m[nt]) * invL[nt];
#pragma unroll
            for (int kt2 = 0; kt2 < 2; ++kt2) {
              own = (S[kt2][0] + S[kt2][1]) + (S[kt2][2] + S[kt2][3]);
              float last = S[kt2][3];
              own += __shfl_xor(own, 1, 64); own += __shfl_xor(own, 2, 64);
              last += __shfl_xor(last, 1, 64); last += __shfl_xor(last, 2, 64);
              const float up = __shfl(last, (lane + 48) & 63, 64);
              const float nb = (q > 0) ? up : carry[nt];
              carry[nt] = up;
              if ((l15 & 3) == 0) imp_row[nt * 512 + ((kbase + kt2 * 16) >> 2) + q] = own + nb;
            }
          }
          if (MODE != 1) {
            const bf16x8 P = as_bf16x8(pack2(S[0][0], S[0][1]), pack2(S[0][2], S[0][3]), pack2(S[1][0], S[1][1]), pack2(S[1][2], S[1][3]));
#pragma unroll
            for (int dt = 0; dt < 4; ++dt) O[dt][nt] = mfma16(va[dt], P, O[dt][nt]);
          }
        }
      }
    }
    }
    jb = nj;
  }
}

DI void accum_lds(unsigned* otl, const f32x4 (&O)[4][4], const float (&sc)[4], bool first) {
  const int lane = threadIdx.x & 63;
#pragma unroll
  for (int dt = 0; dt < 4; ++dt)
#pragma unroll
    for (int nt = 0; nt < 4; ++nt) {
      float v0 = O[dt][nt][0] * sc[nt], v1 = O[dt][nt][1] * sc[nt], v2 = O[dt][nt][2] * sc[nt], v3 = O[dt][nt][3] * sc[nt];
      unsigned* a = otl + ((dt * 4 + nt) * 2) * 64 + lane;
      if (!first) { const unsigned p0 = a[0], p1 = a[64]; v0 += lo_f(p0); v1 += hi_f(p0); v2 += lo_f(p1); v3 += hi_f(p1); }
      a[0] = pack2(v0, v1); a[64] = pack2(v2, v3);
    }
}

DI void attn_item(const Params& p, int cur, int bg, unsigned char* smem, int rep) {
  const int tid = otid(), lane = tid & 63, wave = tid >> 6, l15 = lane & 15, q = lane >> 4;
  const int b = bg >> 2, g = bg & 3;
  const int tl = l15 >> 2, hd = l15 & 3;
  float* imp = (float*)(smem + 18432);
  u64* sel = (u64*)(smem + 18432 + 32768);
  u64* uni = sel + 128;
  const int tokl0 = wave * 16 + tl;
  const int t0 = cur * 64 + tokl0;
  const size_t row0 = (size_t)b * SEQ + t0;
  bf16x8 Qf[4][2];
#pragma unroll
  for (int nt = 0; nt < 4; ++nt)
#pragma unroll
    for (int ks = 0; ks < 2; ++ks) Qf[nt][ks] = *(const bf16x8*)(p.q + (row0 + nt * 4) * 1024 + (g * 4 + hd) * 64 + ks * 32 + q * 8);
  float m[4], ls[4], invL[4], sc[4]; f32x4 O[4][4];
  int lo[4], hi[4];
  unsigned* otl = (unsigned*)imp + wave * 2048;
  const u64 ALL = ~0ull;
  {
  const u16* kcg = p.kc + (size_t)bg * 512 * 64; const u16* vcg = p.vcT + (size_t)bg * 64 * 512;
  const int nkb = ((4 * cur + 2) >> 6) + 1;
#pragma unroll
  for (int nt = 0; nt < 4; ++nt) { m[nt] = -1e30f; ls[nt] = 0.f; invL[nt] = 0.f; lo[nt] = 0; hi[nt] = (t0 + nt * 4 - 31) >> 4; }
  zero_acc(O);
  attn_pass<1>(smem, kcg, vcg, 512, 0, nkb - 1, ALL, ALL, Qf, m, ls, O, lo, hi, nullptr, invL, nullptr);
#pragma unroll
  for (int nt = 0; nt < 4; ++nt) {
    const float L = quad_sum(ls[nt]);
    invL[nt] = (L > 0.f) ? 1.f / L : 0.f;
  }
  attn_pass<2>(smem, kcg, vcg, 512, 0, nkb - 1, ALL, ALL, Qf, m, ls, O, lo, hi, nullptr, invL, imp + tokl0 * 128);
#pragma unroll
  for (int nt = 0; nt < 4; ++nt) sc[nt] = p.gates[(row0 + nt * 4) * 48 + (g * 4 + hd) * 3 + 0];
  __syncthreads();
  {
    u64 un0 = 0, un1 = 0;
    const u64 v0m = (cur >= 63) ? ALL : ((1ull << (cur + 1)) - 1ull);
    const u64 v1m = (cur < 64) ? 0ull : ((cur >= 127) ? ALL : ((1ull << (cur - 63)) - 1ull));
    const u64 lowm = (1ull << lane) - 1ull;
    for (int tk = 0; tk < 16; ++tk) {
      const float* rowp = imp + (wave * 16 + tk) * 128;
      const int j0 = lane, j1 = lane + 64;
      unsigned k0 = 0u, k1 = 0u;
      if (j0 <= cur) k0 = (j0 == 0 || j0 == cur || j0 == cur - 1) ? 0x7F800000u : __float_as_uint(rowp[j0]);
      if (j1 <= cur) k1 = (j1 == cur || j1 == cur - 1) ? 0x7F800000u : __float_as_uint(rowp[j1]);
      unsigned T = 0u;
      for (int bit = 30; bit >= 0; --bit) {
        const unsigned cand = T | (1u << bit);
        const int cnt = __popcll(__ballot(k0 >= cand)) + __popcll(__ballot(k1 >= cand));
        if (cnt >= 16) T = cand;
      }
      const u64 gt0 = __ballot(k0 > T), gt1 = __ballot(k1 > T);
      const int needn = 16 - (__popcll(gt0) + __popcll(gt1));
      const u64 eq0 = __ballot(k0 == T), eq1 = __ballot(k1 == T);
      const int r0 = __popcll(eq0 & lowm), r1 = __popcll(eq0) + __popcll(eq1 & lowm);
      const bool s0 = (k0 > T) || (k0 == T && r0 < needn);
      const bool s1 = (k1 > T) || (k1 == T && r1 < needn);
      const u64 b0 = __ballot(s0) & v0m, b1 = __ballot(s1) & v1m;
      if (lane == 0) { sel[(wave * 16 + tk) * 2] = b0; sel[(wave * 16 + tk) * 2 + 1] = b1; }
      un0 |= b0; un1 |= b1;
    }
    if (lane == 0) { uni[wave * 2] = un0; uni[wave * 2 + 1] = un1; }
  }
  accum_lds(otl, O, sc, true);
  __syncthreads();
  const u64 act0 = uni[0] | uni[2] | uni[4] | uni[6], act1 = uni[1] | uni[3] | uni[5] | uni[7];
#pragma unroll
  for (int nt = 0; nt < 4; ++nt) { m[nt] = -1e30f; ls[nt] = 0.f; lo[nt] = 0; hi[nt] = t0 + nt * 4; }
  zero_acc(O);
#pragma unroll
  for (int nt = 0; nt < 4; ++nt) sc[nt] = p.gates[(row0 + nt * 4) * 48 + (g * 4 + hd) * 3 + 1];
  attn_pass<0>(smem, p.kslc + (size_t)bg * SEQ * 64, p.vslcT + (size_t)bg * 64 * SEQ, SEQ, 0, cur, act0, act1, Qf, m, ls, O, lo, hi, sel + tokl0 * 2, invL, nullptr);
#pragma unroll
  for (int nt = 0; nt < 4; ++nt) {
    const float L = quad_sum(ls[nt]);
    sc[nt] = (L > 0.f) ? sc[nt] / L : 0.f;
  }
  accum_lds(otl, O, sc, false);
#pragma unroll
  for (int nt = 0; nt < 4; ++nt) { m[nt] = -1e30f; ls[nt] = 0.f; lo[nt] = t0 + nt * 4 - 511; hi[nt] = t0 + nt * 4; }
  zero_acc(O);
#pragma unroll
  for (int nt = 0; nt < 4; ++nt) sc[nt] = p.gates[(row0 + nt * 4) * 48 + (g * 4 + hd) * 3 + 2];
  attn_pass<0>(smem, p.kwin + (size_t)bg * SEQ * 64, p.vwinT + (size_t)bg * 64 * SEQ, SEQ, (cur >= 8 ? cur - 8 : 0), cur, ALL, ALL, Qf, m, ls, O, lo, hi, nullptr, invL, nullptr);
#pragma unroll
  for (int nt = 0; nt < 4; ++nt) {
    const float L = quad_sum(ls[nt]);
    sc[nt] = (L > 0.f) ? sc[nt] / L : 0.f;
  }
  accum_lds(otl, O, sc, false);
  if (rep == 1)
#pragma unroll
  for (int nt = 0; nt < 4; ++nt)
#pragma unroll
    for (int dt = 0; dt < 4; ++dt) {
      u16* zp = p.za + (row0 + nt * 4) * 1024 + (g * 4 + hd) * 64 + dt * 16 + q * 4;
      const U2 zv = *(const U2*)zp;
      const unsigned* a = otl + ((dt * 4 + nt) * 2) * 64 + lane;
      const unsigned p0 = a[0], p1 = a[64];
      U2 o;
      o.x = pack2(lo_f(p0) * lo_f(zv.x), hi_f(p0) * hi_f(zv.x));
      o.y = pack2(lo_f(p1) * lo_f(zv.y), hi_f(p1) * hi_f(zv.y));
      *(U2*)zp = o;
    }
  }
}

DI void gemm2_tile(const Params& p, int mt_i, int nt_i, unsigned char* smem) {
  const int m0 = mt_i * 128, n0 = nt_i * 128;
  const int tid = otid(), lane = tid & 63, wave = tid >> 6, wm = wave >> 1, wn = wave & 1, l15 = lane & 15, q = lane >> 4;
  float* rinv = (float*)(smem + 65536 + 64);
  __syncthreads();
  if (tid < 128) {
    const float* sp = p.ssq + (size_t)(m0 + tid) * 16;
    float tot = 0.f;
    for (int k = 0; k < 16; ++k) tot += sp[k];
    rinv[tid] = rsqrtf(tot * (1.f / 1024.f) + EPS);
  }
  f32x4 acc[4][4], res[4][4]; unsigned gte[4][4][2];
  zero_acc(res);
#pragma unroll 1
  for (int br = 0; br < 2; ++br) {
    zero_acc(acc);
    gemm_core<4, 4>(p.hbf + (size_t)m0 * LDH, LDH, p.wt + (size_t)(NG1 + br * 1024 + n0) * LDH, LDH, DM, acc, (u16*)smem);
#pragma unroll
    for (int a = 0; a < 4; ++a)
#pragma unroll
      for (int c = 0; c < 4; ++c) {
        gte[a][c][0] = pack2(sigmoid_f(acc[a][c][0]), sigmoid_f(acc[a][c][1]));
        gte[a][c][1] = pack2(sigmoid_f(acc[a][c][2]), sigmoid_f(acc[a][c][3]));
      }
    zero_acc(acc);
    gemm_core<4, 4>((br ? p.za : p.zs) + (size_t)m0 * DM, DM, (br ? p.wba_t : p.wbs_t) + (size_t)n0 * DM, DM, DM, acc, (u16*)smem);
#pragma unroll
    for (int a = 0; a < 4; ++a) {
      float r[4];
#pragma unroll
      for (int j = 0; j < 4; ++j) r[j] = br ? 1.f : rinv[wm * 64 + a * 16 + q * 4 + j];
#pragma unroll
      for (int c = 0; c < 4; ++c) {
        res[a][c][0] += lo_f(gte[a][c][0]) * r[0] * acc[a][c][0];
        res[a][c][1] += hi_f(gte[a][c][0]) * r[1] * acc[a][c][1];
        res[a][c][2] += lo_f(gte[a][c][1]) * r[2] * acc[a][c][2];
        res[a][c][3] += hi_f(gte[a][c][1]) * r[3] * acc[a][c][3];
      }
    }
  }
  u16* mg = p.q;
#pragma unroll
  for (int a = 0; a < 4; ++a)
#pragma unroll
    for (int c = 0; c < 4; ++c)
#pragma unroll
      for (int j = 0; j < 4; ++j) {
        const int row = m0 + wm * 64 + a * 16 + q * 4 + j; const int col = n0 + wn * 64 + c * 16 + l15;
        mg[(size_t)row * DM + col] = f2bf(res[a][c][j]);
      }
}

DI float dpp_x1(float v) { return __builtin_bit_cast(float, __builtin_amdgcn_update_dpp(0, __builtin_bit_cast(int, v), 0xB1, 0xF, 0xF, true)); }
DI void gemm3_tile(const Params& p, int mt_i, int nt_i, unsigned char* smem) {
  const int m0 = mt_i * 128, n0 = nt_i * 128;
  const int tid = otid(), lane = tid & 63, wave = tid >> 6, wm = wave >> 1, wn = wave & 1, l15 = lane & 15, q = lane >> 4;
  f32x4 acc[4][4]; zero_acc(acc);
  gemm_core<4, 4>(p.q + (size_t)m0 * DM, DM, p.wout_t + (size_t)n0 * DM, DM, DM, acc, (u16*)smem);
  const bool odd = (l15 & 1) != 0;
  const int cpair = l15 & ~1;
#pragma unroll
  for (int mt = 0; mt < 4; ++mt) {
    float ss0 = 0.f, ss1 = 0.f;
    const int rowA = m0 + wm * 64 + mt * 16 + q * 4 + (odd ? 1 : 0);
#pragma unroll
    for (int nt = 0; nt < 4; ++nt) {
      float pp[4];
#pragma unroll
      for (int j = 0; j < 4; ++j) pp[j] = dpp_x1(acc[mt][nt][j]);
      const float a0 = odd ? pp[1] : acc[mt][nt][0], a1 = odd ? acc[mt][nt][1] : pp[0];
      const float b0 = odd ? pp[3] : acc[mt][nt][2], b1 = odd ? acc[mt][nt][3] : pp[2];
      const int col = n0 + wn * 64 + nt * 16 + cpair;
      const f32x2 xa = __builtin_nontemporal_load((const f32x2*)(p.x + (size_t)rowA * DM + col));
      const f32x2 xb = __builtin_nontemporal_load((const f32x2*)(p.x + (size_t)(rowA + 2) * DM + col));
      const f32x2 va = {a0 + xa[0], a1 + xa[1]}, vb = {b0 + xb[0], b1 + xb[1]};
      *(f32x2*)(p.out + (size_t)rowA * DM + col) = va;
      *(f32x2*)(p.out + (size_t)(rowA + 2) * DM + col) = vb;
      ss0 += va[0] * va[0] + va[1] * va[1];
      ss1 += vb[0] * vb[0] + vb[1] * vb[1];
    }
    ss0 += __shfl_xor(ss0, 2, 64); ss0 += __shfl_xor(ss0, 4, 64); ss0 += __shfl_xor(ss0, 8, 64);
    ss1 += __shfl_xor(ss1, 2, 64); ss1 += __shfl_xor(ss1, 4, 64); ss1 += __shfl_xor(ss1, 8, 64);
    if (l15 < 2) {
      p.ssq2[(size_t)rowA * 16 + nt_i * 2 + wn] = ss0;
      p.ssq2[(size_t)(rowA + 2) * 16 + nt_i * 2 + wn] = ss1;
    }
  }
}

struct BarState { unsigned epoch, myx, nx_wg, n_xcc; };
DI unsigned xcc_id() { return (unsigned)__builtin_amdgcn_s_getreg((3 << 11) | 20) & 0xFu; }
DI void grid_barrier(unsigned* ctl, BarState& st) {
  st.epoch += 1;
  const unsigned epoch = st.epoch;
  __syncthreads();
  if (threadIdx.x < 64) {
    unsigned last = 0u;
    if (threadIdx.x == 0) {
      if (epoch == 1u) {
        __builtin_amdgcn_fence(__ATOMIC_RELEASE, "agent");
        const unsigned v = __hip_atomic_fetch_add(ctl, 1u, __ATOMIC_RELAXED, __HIP_MEMORY_SCOPE_AGENT) + 1u;
        last = (v == gridDim.x) ? 1u : 0u;
      } else {
        const unsigned a = __hip_atomic_fetch_add(ctl + 256 + st.myx * 32, 1u, __ATOMIC_RELAXED, __HIP_MEMORY_SCOPE_AGENT) + 1u;
        if (a == (epoch - 1u) * st.nx_wg) {
          __builtin_amdgcn_fence(__ATOMIC_RELEASE, "agent");
          const unsigned v = __hip_atomic_fetch_add(ctl + 32, 1u, __ATOMIC_RELAXED, __HIP_MEMORY_SCOPE_AGENT) + 1u;
          last = (v == (epoch - 1u) * st.n_xcc) ? 1u : 0u;
        }
      }
    }
    last = (unsigned)__builtin_amdgcn_readfirstlane((int)last);
    if (last) {
      __builtin_amdgcn_fence(__ATOMIC_ACQUIRE, "agent");
      __builtin_amdgcn_fence(__ATOMIC_RELEASE, "agent");
      for (unsigned g = threadIdx.x; g < ((gridDim.x + 7u) >> 3); g += 64u) __hip_atomic_store(ctl + 1008 + g * 32, epoch, __ATOMIC_RELAXED, __HIP_MEMORY_SCOPE_AGENT);
    }
    if (threadIdx.x == 0) {
      unsigned* f = ctl + 1008 + (blockIdx.x >> 3) * 32;
      while (__hip_atomic_load(f, __ATOMIC_RELAXED, __HIP_MEMORY_SCOPE_AGENT) < epoch) __builtin_amdgcn_s_sleep(64);
      __builtin_amdgcn_fence(__ATOMIC_ACQUIRE, "agent");
      if (epoch == 1u) {
        st.nx_wg = __hip_atomic_load(ctl + 768 + st.myx * 8, __ATOMIC_RELAXED, __HIP_MEMORY_SCOPE_AGENT);
        unsigned n = 0u;
        for (int x = 0; x < 16; ++x) n += (__hip_atomic_load(ctl + 768 + x * 8, __ATOMIC_RELAXED, __HIP_MEMORY_SCOPE_AGENT) != 0u) ? 1u : 0u;
        st.n_xcc = n;
      }
    }
  }
  __syncthreads();
}

__global__ void __launch_bounds__(256, 2) hybrid_fwd(Params p) {
  cg::grid_group grid = cg::this_grid();
  extern __shared__ __attribute__((aligned(16))) unsigned char smem[];
  const int tid = threadIdx.x;
  BarState epoch{}; unsigned* bar = p.counter + 16;
  epoch.myx = xcc_id();
  if (tid == 0) __hip_atomic_fetch_add(bar + 768 + epoch.myx * 8, 1u, __ATOMIC_RELAXED, __HIP_MEMORY_SCOPE_AGENT);
  if (p.counter == nullptr) grid.sync();
  grid_barrier(bar, epoch);
  phase0(p, smem);
#ifdef PROBE_P0X2
  phase0(p, smem);
#endif
  grid_barrier(bar, epoch);
  patch_walk<16, 4>(128, 52, [&](int mt, int nt) { gemm1_tile(p, mt, nt, smem); });
  for (int t = blockIdx.x; t < 256; t += gridDim.x) gemm1_mini_tile(p, t, smem);
#ifdef PROBE_G1X2
  patch_walk(128, 53, [&](int mt, int nt) { gemm1_tile(p, mt, nt, smem); });
#endif
  grid_barrier(bar, epoch);
  for (int t = blockIdx.x; t < 512; t += gridDim.x) preconv_item(p, t);
  grid_barrier(bar, epoch);
  {
    int* s_item = (int*)(smem + 65536);
    for (;;) {
      __syncthreads();
      if (tid == 0) *s_item = (int)atomicAdd(p.counter + 9, 1u);
      __syncthreads();
      const int t = *s_item;
      if (t >= 256 + 1024) break;
      if (t < 256) cmp_a_tile(p, t, smem); else ssd_states_item(p, t - 256, smem);
    }
  }
  grid_barrier(bar, epoch);
#ifdef PROBE_P37X2
  for (int t = blockIdx.x; t < 64 + 256; t += gridDim.x) {
    if (t < 64) cmp_b_tile(p, t, smem);
    else {
      const int e4 = (t - 64) * 256 + threadIdx.x; const int b = e4 >> 15, h = (e4 >> 11) & 15, r = e4 & 2047;
      float4* st = (float4*)p.states;
      for (int c = 0; c < 32; ++c) { const size_t idx = (size_t)((b * 32 + c) * 16 + h) * 2048 + r; float4 v = st[idx]; v.x += 0.f; st[idx] = v; }
    }
  }
#endif
  for (int t = blockIdx.x; t < 64 + 256; t += gridDim.x) { if (t < 64) cmp_b_tile(p, t, smem); else scan_item(p, t - 64); }
  grid_barrier(bar, epoch);
  {
    int* s_item = (int*)(smem + 65536);
#ifndef SKIP_ATTN
    for (;;) {
      __syncthreads();
      if (tid == 0) *s_item = (int)atomicAdd(p.counter + (blockIdx.x & 7), 1u);
      __syncthreads();
      const int item = *s_item;
#ifdef PROBE_ATTNX2
      if (item >= 256) break;
      attn_item(p, 127 - (item >> 1), blockIdx.x & 7, smem, item & 1);
#else
      if (item >= 128) break;
      attn_item(p, 127 - item, blockIdx.x & 7, smem, 1);
#endif
    }
#endif
#ifndef SKIP_SSDY
    for (;;) {
      __syncthreads();
      if (tid == 0) *s_item = (int)atomicAdd(p.counter + 8, 1u);
      __syncthreads();
      const int item = *s_item;
#ifdef PROBE_SSDYX2
      if (item >= 2048) break;
      ssd_y_item(p, item & 1023, smem, item >> 10);
#else
      if (item >= 1024) break;
      ssd_y_item(p, item, smem, 1);
#endif
    }
#endif
  }
  grid_barrier(bar, epoch);
  patch_walk(128, 8, [&](int mt, int nt) { gemm2_tile(p, mt, nt, smem); });
  grid_barrier(bar, epoch);
  patch_walk(128, 8, [&](int mt, int nt) { gemm3_tile(p, mt, nt, smem); });
  grid_barrier(bar, epoch);
#ifdef PROBE_SYNCX
  for (int i = 0; i < 10; ++i) grid_barrier(bar, epoch);
#endif
  {
    const int lane = tid & 63, wave = tid >> 6;
#ifdef PROBE_P37X2
    for (int it = blockIdx.x; it < NTOK / 4; it += gridDim.x) {
      const int row = it * 4 + wave;
      float4* o = (float4*)(p.out + (size_t)row * DM);
      for (int k = 0; k < 4; ++k) { float4 v = o[lane + 64 * k]; v.x += 0.f; o[lane + 64 * k] = v; }
    }
    __syncthreads();
#endif
    for (int it = blockIdx.x; it < NTOK / 4; it += gridDim.x) {
      const int row = it * 4 + wave;
      const float4* sp = (const float4*)(p.ssq2 + (size_t)row * 16);
      const float4 s0 = sp[0], s1 = sp[1], s2 = sp[2], s3 = sp[3];
      const float tot = ((s0.x + s0.y) + (s0.z + s0.w)) + ((s1.x + s1.y) + (s1.z + s1.w)) + ((s2.x + s2.y) + (s2.z + s2.w)) + ((s3.x + s3.y) + (s3.z + s3.w));
      const float r = rsqrtf(tot * (1.f / 1024.f) + EPS);
      float4* o = (float4*)(p.out + (size_t)row * DM);
#pragma unroll
      for (int k = 0; k < 4; ++k) {
        float4 v = o[lane + 64 * k]; const float4 w = ((const float4*)p.final_w)[lane + 64 * k];
        v.x *= r * w.x; v.y *= r * w.y; v.z *= r * w.z; v.w *= r * w.w;
        __builtin_nontemporal_store(f32x4{v.x, v.y, v.z, v.w}, (f32x4*)o + lane + 64 * k);
      }
    }
  }
}

extern "C" void kernel_launch(void* const* d_in, const int* in_sizes, int n_in, void* d_out, int out_size, void* d_ws, size_t ws_size, hipStream_t stream) {
  static int grid_blocks = 0;
  if (!grid_blocks) {
    int dev = 0, cus = 0, per_cu = 0;
    hipGetDevice(&dev);
    hipDeviceGetAttribute(&cus, hipDeviceAttributeMultiprocessorCount, dev);
    hipFuncSetAttribute((const void*)hybrid_fwd, hipFuncAttributeMaxDynamicSharedMemorySize, SMEM_DYN);
    hipOccupancyMaxActiveBlocksPerMultiprocessor(&per_cu, hybrid_fwd, 256, SMEM_DYN);
    if (per_cu < 1) per_cu = 1;
    if (per_cu > 2) per_cu = 2;
    grid_blocks = cus * per_cu;
    if (grid_blocks > 768) grid_blocks = 768;
    grid_blocks &= ~7;
  }
  Params p{};
  const float* const* in = (const float* const*)d_in;
  p.x = in[0]; p.norm_w = in[1]; p.w_in = in[2]; p.conv_w = in[3]; p.conv_b = in[4]; p.dt_bias = in[5]; p.a_log = in[6]; p.d_skip = in[7];
  p.ssm_norm_w = in[8]; p.cmp_pos_k = in[9]; p.cmp_pos_v = in[10]; p.ck_w1 = in[11]; p.ck_b1 = in[12]; p.ck_w2 = in[13];
  p.cv_w1 = in[14]; p.cv_b1 = in[15]; p.cv_w2 = in[16]; p.w_bs = in[17]; p.w_ba = in[18]; p.w_out = in[19]; p.final_w = in[20];
  p.out = (float*)d_out;
  p.xbc = (u16*)d_out;
  unsigned char* w = (unsigned char*)d_ws; size_t off = 0;
  auto take = [&](size_t bytes) { unsigned char* r = w + off; off += (bytes + 255) & ~(size_t)255; return r; };
  p.hbf = (u16*)take((size_t)NTOK * LDH * 2);
  p.wt = (u16*)take((size_t)WT_ROWS * LDH * 2);
  p.wbs_t = (u16*)take((size_t)DM * DM * 2); p.wba_t = (u16*)take((size_t)DM * DM * 2); p.wout_t = (u16*)take((size_t)DM * DM * 2);
  p.w1k_t = (u16*)take((size_t)256 * 2048 * 2); p.w1v_t = (u16*)take((size_t)256 * 2048 * 2);
  p.w2k_t = (u16*)take((size_t)64 * 256 * 2); p.w2v_t = (u16*)take((size_t)64 * 256 * 2);
  p.zs = (u16*)take((size_t)NTOK * DM * 2);
  p.q = (u16*)take((size_t)NTOK * DM * 2);
  const size_t kvb = (size_t)NTOK * 256 * 2;
  p.kcmp = (u16*)take(kvb); p.vcmp = (u16*)take(kvb); p.kslc = (u16*)take(kvb); p.vslcT = (u16*)take(kvb); p.kwin = (u16*)take(kvb); p.vwinT = (u16*)take(kvb);
  p.za = (u16*)take((size_t)NTOK * DM * 2);
  p.states = (float*)take((size_t)2 * 32 * 16 * 8192 * 4);
  p.hid_k = (u16*)take((size_t)4096 * 256 * 2); p.hid_v = (u16*)take((size_t)4096 * 256 * 2);
  p.kc = (u16*)take((size_t)8 * 512 * 64 * 2); p.vcT = (u16*)take((size_t)8 * 64 * 512 * 2);
  p.gates = (float*)take((size_t)NTOK * 48 * 4);
  p.dtv = (float*)take((size_t)NTOK * 16 * 4);
  p.ssq = (float*)take((size_t)NTOK * 16 * 4); p.ssq2 = (float*)take((size_t)NTOK * 16 * 4);
  p.rope = (float*)take((size_t)SEQ * 32 * 2 * 4);
  p.peb = (float*)take(64 * 256 * 4);
  p.cd = (float*)take(2 * 32 * 16 * 4);
  p.counter = (unsigned*)take(16384);
  if (off > ws_size) { fprintf(stderr, "kernel_launch: workspace too small: need %zu, have %zu\n", off, ws_size); return; }
  if (hipMemsetAsync(p.counter, 0, 16384, stream) != hipSuccess) { fprintf(stderr, "kernel_launch: memset of control words failed\n"); return; }
  void* args[] = {&p};
  hipError_t e = hipLaunchCooperativeKernel((void*)hybrid_fwd, dim3(grid_blocks), dim3(256), args, SMEM_DYN, stream);
  if (e != hipSuccess) fprintf(stderr, "cooperative launch failed: %s (grid %d)\n", hipGetErrorString(e), grid_blocks);
}
```
